# Optimizing an MI355X kernel written in HIP

```python
import math
import jax, jax.numpy as jnp
from jax import lax
import numpy as np

D_MODEL = 1024
BATCH = 8
SEQ = 2048
DEPTH = 2

D_CONV = 512
CONV_GROUPS = 8
CONV_WIDTH = 3
N_HEADS = 8
QK_NOPE = 64
QK_ROPE = 32
V_HEAD = 64
Q_LORA = 384
KV_LORA = 256
ROPE_THETA = 10000.0
Q_BLOCK = 128
D_FF = 2816
N_EXPERTS = 8
TOP_K = 2
D_FF_EXPERT = 1408
N_DENSE = (DEPTH + 1) // 2
N_MOE = DEPTH // 2
EPS = 1e-6
IN_WIDTHS = (D_CONV, D_CONV, D_CONV, Q_LORA, KV_LORA, QK_ROPE, D_MODEL, D_MODEL)
D_IN = sum(IN_WIDTHS)

kernel_name = "hybrid_gated_conv_mla_moe_trunk"


def rmsnorm(x, g):
    xf = x.astype(jnp.float32)
    y = xf * lax.rsqrt(jnp.mean(xf * xf, axis=-1, keepdims=True) + EPS)
    return (y * g.astype(jnp.float32)).astype(x.dtype)


def rope_tables(positions, dtype):
    inv_freq = ROPE_THETA ** (-jnp.arange(0, QK_ROPE, 2, dtype=jnp.float32) / QK_ROPE)
    ang = positions.astype(jnp.float32)[..., None] * inv_freq
    return jnp.cos(ang).astype(dtype), jnp.sin(ang).astype(dtype)


def apply_rope(x, cos, sin):
    half = x.shape[-1] // 2
    x1, x2 = x[..., :half], x[..., half:]
    return jnp.concatenate([x1 * cos - x2 * sin, x2 * cos + x1 * sin], axis=-1)


def causal_short_conv(u, w):
    s = u.shape[1]
    up = jnp.pad(u, ((0, 0), (CONV_WIDTH - 1, 0), (0, 0)))
    return sum(up[:, k:k + s] * w[k] for k in range(CONV_WIDTH))


def causal_block_attention(q, k, v):
    b, s, h, dqk = q.shape
    nb = s // Q_BLOCK
    scale = 1.0 / math.sqrt(dqk)
    qb = q.reshape(b, nb, Q_BLOCK, h, dqk).transpose(1, 0, 2, 3, 4)
    key_pos = jnp.arange(s)

    def one_block(args):
        q_blk, i = args
        sc = jnp.einsum('bqhd,bkhd->bhqk', q_blk, k).astype(jnp.float32) * scale
        q_pos = i * Q_BLOCK + jnp.arange(Q_BLOCK)
        mask = key_pos[None, :] <= q_pos[:, None]
        sc = jnp.where(mask[None, None], sc, -1e30)
        p = jax.nn.softmax(sc, axis=-1).astype(v.dtype)
        return jnp.einsum('bhqk,bkhd->bqhd', p, v)

    out = lax.map(one_block, (qb, jnp.arange(nb)))
    return out.transpose(1, 0, 2, 3, 4).reshape(b, s, h, v.shape[-1])


def token_mixer(xn, cos, sin, w_in, conv_w, w_conv_out, q_norm, w_uq, kv_norm, w_ukv, w_mla_out, w_o):
    b, s, _ = xn.shape
    offsets = list(np.cumsum(IN_WIDTHS)[:-1])
    b_g, c_g, u, c_q, c_kv, k_r, g_conv, g_mla = jnp.split(xn @ w_in, offsets, axis=-1)

    y_conv = (b_g * causal_short_conv(c_g * u, conv_w)) @ w_conv_out

    q = (rmsnorm(c_q, q_norm) @ w_uq).reshape(b, s, N_HEADS, QK_NOPE + QK_ROPE)
    q_nope, q_pe = q[..., :QK_NOPE], q[..., QK_NOPE:]
    q_pe = apply_rope(q_pe, cos[:, :, None, :], sin[:, :, None, :])
    kv = (rmsnorm(c_kv, kv_norm) @ w_ukv).reshape(b, s, N_HEADS, QK_NOPE + V_HEAD)
    k_nope, v = kv[..., :QK_NOPE], kv[..., QK_NOPE:]
    k_pe = apply_rope(k_r, cos, sin)
    k_pe = jnp.broadcast_to(k_pe[:, :, None, :], (b, s, N_HEADS, QK_ROPE))
    q_full = jnp.concatenate([q_nope, q_pe], axis=-1)
    k_full = jnp.concatenate([k_nope, k_pe], axis=-1)
    attn = causal_block_attention(q_full, k_full, v).reshape(b, s, N_HEADS * V_HEAD)
    y_mla = attn @ w_mla_out

    merged = jax.nn.sigmoid(g_conv) * y_conv + jax.nn.sigmoid(g_mla) * y_mla
    return merged @ w_o


def swiglu(x, wg, wu, wd):
    return (jax.nn.silu(x @ wg) * (x @ wu)) @ wd


def moe_swiglu(x, router, wg, wu, wd):
    b, s, d = x.shape
    xt = x.reshape(b * s, d)
    logits = (xt @ router).astype(jnp.float32)
    top_vals, top_idx = lax.top_k(logits, TOP_K)
    top_w = jax.nn.softmax(top_vals, axis=-1)
    combine = jnp.sum(jax.nn.one_hot(top_idx, N_EXPERTS, dtype=jnp.float32) * top_w[..., None], axis=1)
    combine = combine.astype(x.dtype)
    y = jnp.zeros_like(xt)
    for e in range(N_EXPERTS):
        y = y + combine[:, e:e + 1] * swiglu(xt, wg[e], wu[e], wd[e])
    return y.reshape(b, s, d)


def setup_inputs(seed: int = 0) -> dict:
    key = jax.random.key(seed)
    ks = jax.random.split(key, 24)
    f32 = jnp.float32

    def nrm(k, shape, fan_in):
        return jax.random.normal(k, shape, f32) * (fan_in ** -0.5)

    def gain(k, shape):
        return 1.0 + 0.02 * jax.random.normal(k, shape, f32)

    x = jax.random.normal(ks[0], (BATCH, SEQ, D_MODEL), f32)
    offset = jax.random.randint(ks[1], (BATCH, 1), 0, 1024, dtype=jnp.int32)
    positions = offset + jnp.arange(SEQ, dtype=jnp.int32)[None, :]
    return {
        "x": x,
        "positions": positions,
        "attn_norm": gain(ks[2], (DEPTH, D_MODEL)),
        "w_in": nrm(ks[3], (DEPTH, D_MODEL, D_IN), D_MODEL),
        "conv_w": nrm(ks[4], (DEPTH, CONV_WIDTH, D_CONV), CONV_WIDTH),
        "w_conv_out": nrm(ks[5], (DEPTH, D_CONV, D_MODEL), D_CONV),
        "q_norm": gain(ks[6], (DEPTH, Q_LORA)),
        "w_uq": nrm(ks[7], (DEPTH, Q_LORA, N_HEADS * (QK_NOPE + QK_ROPE)), Q_LORA),
        "kv_norm": gain(ks[8], (DEPTH, KV_LORA)),
        "w_ukv": nrm(ks[9], (DEPTH, KV_LORA, N_HEADS * (QK_NOPE + V_HEAD)), KV_LORA),
        "w_mla_out": nrm(ks[10], (DEPTH, N_HEADS * V_HEAD, D_MODEL), N_HEADS * V_HEAD),
        "w_o": nrm(ks[11], (DEPTH, D_MODEL, D_MODEL), D_MODEL),
        "ffn_norm": gain(ks[12], (DEPTH, D_MODEL)),
        "w_gate": nrm(ks[13], (N_DENSE, D_MODEL, D_FF), D_MODEL),
        "w_up": nrm(ks[14], (N_DENSE, D_MODEL, D_FF), D_MODEL),
        "w_down": nrm(ks[15], (N_DENSE, D_FF, D_MODEL), D_FF),
        "router": nrm(ks[16], (N_MOE, D_MODEL, N_EXPERTS), D_MODEL),
        "w_gate_e": nrm(ks[17], (N_MOE, N_EXPERTS, D_MODEL, D_FF_EXPERT), D_MODEL),
        "w_up_e": nrm(ks[18], (N_MOE, N_EXPERTS, D_MODEL, D_FF_EXPERT), D_MODEL),
        "w_down_e": nrm(ks[19], (N_MOE, N_EXPERTS, D_FF_EXPERT, D_MODEL), D_FF_EXPERT),
        "final_norm": gain(ks[20], (D_MODEL,)),
    }


def reference(x, positions, attn_norm, w_in, conv_w, w_conv_out, q_norm, w_uq, kv_norm, w_ukv,
              w_mla_out, w_o, ffn_norm, w_gate, w_up, w_down, router, w_gate_e, w_up_e, w_down_e,
              final_norm):
    cos, sin = rope_tables(positions, x.dtype)
    for l in range(DEPTH):
        xn = rmsnorm(x, attn_norm[l])
        x = x + token_mixer(xn, cos, sin, w_in[l], conv_w[l], w_conv_out[l], q_norm[l], w_uq[l],
                            kv_norm[l], w_ukv[l], w_mla_out[l], w_o[l])
        hn = rmsnorm(x, ffn_norm[l])
        if l % 2 == 0:
            i = l // 2
            x = x + swiglu(hn, w_gate[i], w_up[i], w_down[i])
        else:
            i = l // 2
            x = x + moe_swiglu(hn, router[i], w_gate_e[i], w_up_e[i], w_down_e[i])
    return rmsnorm(x, final_norm)
```

```cpp
#include <hip/hip_runtime.h>
#ifndef DUP3
#define DUP3 1
#endif
#ifndef DUPE
#define DUPE 1
#endif
#ifndef DUPC
#define DUPC 1
#endif
#ifndef DUP5
#define DUP5 1
#endif
#ifndef DUP7
#define DUP7 1
#endif
#ifndef DUPB
#define DUPB 1
#endif
#ifndef DUP2
#define DUP2 1
#endif
#ifndef DUP4
#define DUP4 1
#endif
#ifndef DUP0
#define DUP0 1
#endif
#ifndef DUP1
#define DUP1 1
#endif
#ifndef DUP6
#define DUP6 1
#endif
#ifndef DUPM
#define DUPM 1
#endif
#include <hip/hip_bf16.h>
#include <cstdio>
#include <cstdint>
#include <cmath>

constexpr int BATCH = 8, SEQ = 2048, DM = 1024, M = BATCH * SEQ;
constexpr int DCONV = 512, QLORA = 384, KVLORA = 256, NH = 8, DQK = 96, DVH = 64;
constexpr int DIN = 4256, DINP = 4352;
constexpr int DFF = 2816, NE = 8, DFFE = 1408;
constexpr float EPS = 1e-6f;
constexpr float QSCALE = 0.10206207261596577f * 1.4426950408889634f;

#define GAS __attribute__((address_space(1)))
#define LAS __attribute__((address_space(3)))
typedef unsigned short bf16;
typedef unsigned v4u __attribute__((ext_vector_type(4)));
typedef unsigned v2u __attribute__((ext_vector_type(2)));
typedef float f32x4 __attribute__((ext_vector_type(4)));
typedef float f32x2 __attribute__((ext_vector_type(2)));
typedef short bf16x8 __attribute__((ext_vector_type(8)));
typedef GAS unsigned gu32;

__device__ __forceinline__ int fresh_lane() { int l; asm volatile("v_mbcnt_lo_u32_b32 %0, -1, 0\n\tv_mbcnt_hi_u32_b32 %0, -1, %0" : "=v"(l)); return l; }
template <int MASK> __device__ __forceinline__ float swz_xor(float v) { return __builtin_bit_cast(float, __builtin_amdgcn_ds_swizzle(__builtin_bit_cast(int, v), (MASK << 10) | 0x1f)); }
__device__ __forceinline__ float xadd32(float v) { auto rr = __builtin_amdgcn_permlane32_swap(__float_as_uint(v), __float_as_uint(v), false, false); return __uint_as_float(rr[0]) + __uint_as_float(rr[1]); }
__device__ __forceinline__ float xadd_16_32(float q) { q += swz_xor<16>(q); return xadd32(q); }
typedef __bf16 bf16x2_t __attribute__((ext_vector_type(2)));
__device__ __forceinline__ unsigned cvt_pk_bf16(float lo, float hi) { const f32x2 v = {lo, hi}; const bf16x2_t b = __builtin_convertvector(v, bf16x2_t); return __builtin_bit_cast(unsigned, b); }
__device__ __forceinline__ float bflo(unsigned w) { return __uint_as_float(w << 16); }
__device__ __forceinline__ float bfhi(unsigned w) { return __uint_as_float(w & 0xffff0000u); }
__device__ __forceinline__ v4u pack8(const f32x4 a, const f32x4 b) { v4u w; w.x = cvt_pk_bf16(a[0], a[1]); w.y = cvt_pk_bf16(a[2], a[3]); w.z = cvt_pk_bf16(b[0], b[1]); w.w = cvt_pk_bf16(b[2], b[3]); return w; }
__device__ __forceinline__ void unpack8(const v4u w, f32x4& a, f32x4& b) { a = (f32x4){bflo(w.x), bfhi(w.x), bflo(w.y), bfhi(w.y)}; b = (f32x4){bflo(w.z), bfhi(w.z), bflo(w.w), bfhi(w.w)}; }
__device__ __forceinline__ float sigmoidf_(float v) { return __builtin_amdgcn_rcpf(1.0f + __builtin_amdgcn_exp2f(-1.4426950408889634f * v)); }

constexpr size_t MiB = 1u << 20;
constexpr size_t WS_CTL = 0, CTL_ZERO_BYTES = 64 * 1024;
constexpr size_t WS_PART = 1 * MiB;
constexpr size_t WS_SSQQ = 2 * MiB;
constexpr size_t WS_SSQKV = 2 * MiB + 512 * 1024;
constexpr size_t WS_RSTD1 = 2 * MiB + 768 * 1024;
constexpr size_t WS_COS = 3 * MiB, WS_SIN = 4 * MiB;
constexpr size_t WS_TOPE = 5 * MiB, WS_TOPW = 5 * MiB + 128 * 1024, WS_TOPP = 5 * MiB + 256 * 1024;
constexpr size_t WS_LIST = 5 * MiB + 512 * 1024;
constexpr size_t WS_W = 7 * MiB;
constexpr size_t W_IN_EL = (size_t)DINP * DM, W_UQ_EL = 768 * 384, W_UKV_EL = 1024 * 256, W_CM_EL = 1024 * 512, W_O_EL = 1024 * 1024;
constexpr size_t WO_IN = 0, WO_UQ = WO_IN + 2 * W_IN_EL, WO_UKV = WO_UQ + 2 * W_UQ_EL, WO_C = WO_UKV + 2 * W_UKV_EL, WO_M = WO_C + 2 * W_CM_EL,
                 WO_O = WO_M + 2 * W_CM_EL, WO_GU = WO_O + 2 * W_O_EL, WO_D = WO_GU + (size_t)2 * DFF * DM, WO_END = WO_D + (size_t)DM * DFF;
static_assert(WO_END * 2 <= 44 * MiB, "weights");
constexpr size_t WS_XB = 51 * MiB;
constexpr size_t WS_ACT = 83 * MiB;
constexpr size_t WS_CU = WS_ACT, WS_CQ = WS_CU + 16 * MiB, WS_CKV = WS_CQ + 12 * MiB, WS_ZATT = WS_CKV + 8 * MiB, WS_Q = WS_ZATT + 32 * MiB,
                 WS_K = WS_Q + 24 * MiB, WS_V = WS_K + 24 * MiB, WS_S1 = WS_V + 16 * MiB, WS_S2 = WS_S1 + 32 * MiB, WS_END = WS_S2 + 32 * MiB;
constexpr size_t WS_X1B = 246 * MiB;
constexpr size_t WS_TMP = WS_Q, WS_MERGED = WS_Q + 32 * MiB;
constexpr size_t WS_HD = WS_Q;
constexpr size_t WS_WGUE = WS_ACT, WS_WDE = WS_ACT + 44 * MiB;
constexpr size_t WS_HMOE = WS_Q;
constexpr size_t WS_Y = WS_W;
constexpr int MOE_ROWS = 2 * M + NE * 256;
static_assert(WS_HMOE + (size_t)MOE_ROWS * DFFE * 2 <= WS_END && WS_Y + (size_t)MOE_ROWS * DM * 2 <= WS_ACT && WS_WDE + (size_t)NE * DM * DFFE * 2 <= WS_Q, "moe map");
static_assert(WS_HD + (size_t)M * DFF * 2 <= WS_END, "dense hidden");
static_assert(WS_X1B >= WS_HMOE + (size_t)MOE_ROWS * DFFE * 2 && WS_X1B + (size_t)M * DM * 2 <= WS_END, "x1b");
constexpr int CW_BAR = 4096, CW_CNT = 256, CW_RDY = 320, CW_RDY2 = 384;

namespace pg8 {
#define PG8_LAS __attribute__((address_space(3)))
typedef unsigned short bf16_t;
constexpr int BM = 256, BK = 64, HALF = 128, HTB = HALF * BK * 2, STAGE_BYTES = 8 * HTB, NXCD = 8, WGM = 8;
__host__ __device__ __forceinline__ int lds_byte(int r, int c) { const int st = (r >> 4) * 2 + (c >> 5), rr = r & 15, cc = c & 31, ob = rr * 64 + cc * 2; return st * 1024 + (ob ^ (((ob >> 9) & 1) << 5)); }
__host__ __device__ __forceinline__ void stage_rc(int b, int& R, int& C) { const int st = b / 1024, sb = b % 1024, swz = sb ^ (((sb >> 9) & 1) << 5); R = (st >> 1) * 16 + swz / 64; C = (st & 1) * 32 + (swz % 64) / 2; }
__host__ __device__ __forceinline__ int perm32(int rho) { const int n = rho >> 4, i = rho & 15; return 8 * (i >> 2) + 4 * n + (i & 3); }

struct Unit { int pm, pn; unsigned bo; int lo, gn; };
struct Gemm { const bf16_t* A; const bf16_t* Bt; int lda; int K; };

struct StaticOrder {
    int nM, nN, nwg, G, c;
    __device__ void init(int Mr, int N, int G_, int c_) { nM = Mr / BM; nN = N / BM; nwg = nM * nN; G = G_; c = c_; }
    __device__ bool next(int i, Unit& u) const {
        const long L = (long)i * G + c; if (L >= nwg) return false;
        int wgid = (int)L; { const int q = nwg / NXCD, r = nwg % NXCD, xcd = wgid % NXCD, off = wgid / NXCD; wgid = (xcd < r ? xcd * (q + 1) : r * (q + 1) + (xcd - r) * q) + off; }
        const int nig = WGM * nN, gid = wgid / nig, fm = gid * WGM, gsz = (nM - fm) < WGM ? (nM - fm) : WGM;
        u.pm = fm + ((wgid % nig) % gsz); u.pn = (wgid % nig) / gsz; u.bo = 0u; u.lo = 0; u.gn = 0; return true;
    }
};
struct OneTileOrder { int pm, pn; bool has;
    __device__ bool next(int i, Unit& u) const { if (i > 0 || !has) return false; u.pm = pm; u.pn = pn; u.bo = 0u; u.lo = 0; u.gn = 0; return true; } };
template <bool UP> struct MoeOrderT {
    int nM, nN, nwg, G, c, sk; const PG8_LAS int* tab; unsigned bstride;
    __device__ void init(const PG8_LAS int* tab_, int N, unsigned bstride_, int G_, int c_, int sk_ = 0) {
        tab = tab_; nM = __builtin_amdgcn_readfirstlane(tab_[NE]); nN = N / BM; sk = sk_; nwg = nM * nN - (UP ? 0 : sk_); G = G_; c = c_; bstride = bstride_;
    }
    __device__ __forceinline__ void tile(int wgid, Unit& u) const {
        const int nig = WGM * nN, gid = wgid / nig, fm = gid * WGM, gsz = (nM - fm) < WGM ? (nM - fm) : WGM;
        u.pm = fm + ((wgid % nig) % gsz); u.pn = (wgid % nig) / gsz;
        int e = 0;
#pragma unroll
        for (int j = 1; j < NE; ++j) if (u.pm >= __builtin_amdgcn_readfirstlane(tab[j])) e = j;
        const int t0 = __builtin_amdgcn_readfirstlane(tab[e]), n0 = __builtin_amdgcn_readfirstlane(tab[NE + 1 + e]);
        const int lt = u.pm - t0; u.bo = (unsigned)e * bstride; u.lo = e * M + lt * BM; u.gn = n0 - lt * BM;
    }
    __device__ bool next(int i, Unit& u) const {
        long L = (long)i * G + c;
        if constexpr (UP) { const int n6 = nwg - 5 * G;
            if (sk > 0 && n6 >= 0 && n6 + 2 * sk <= G && nwg <= 6 * G) {
                if (c >= G - sk) { if (i >= 4) return false; }
                else if (i == 5 && c >= n6) { if (c - n6 >= sk) return false; L = 5L * G - sk + (c - n6); } } }
        if (L >= nwg) return false;
        int wgid = (int)L; { const int q = nwg / NXCD, r = nwg % NXCD, xcd = wgid % NXCD, off = wgid / NXCD; wgid = (xcd < r ? xcd * (q + 1) : r * (q + 1) + (xcd - r) * q) + off; }
        tile(wgid + (UP ? 0 : sk), u); return true;
    }
};
typedef MoeOrderT<false> MoeOrder;
struct MoeOne { MoeOrder O; int wg;
    __device__ bool next(int i, Unit& u) const { if (i > 0) return false; O.tile(wg, u); return true; } };

struct RsNone { struct Regs {}; __device__ __forceinline__ Regs pre(const Unit&, int) const { return {}; } __device__ __forceinline__ void post(PG8_LAS float*, const Regs&, int) const {} };
template <int NP> struct RsPart {
    const float* part; float inv_n;
    struct Regs { f32x4 v[NP / 4]; };
    __device__ __forceinline__ Regs pre(const Unit& u, int tid) const { Regs r;
#pragma unroll
        for (int j = 0; j < NP / 4; ++j) r.v[j] = (f32x4){0.f, 0.f, 0.f, 0.f};
        if (tid < 256) { const f32x4* p = (const f32x4*)(part + (size_t)(u.pm * BM + tid) * NP);
#pragma unroll
            for (int j = 0; j < NP / 4; ++j) r.v[j] = p[j]; }
        return r; }
    __device__ __forceinline__ void post(PG8_LAS float* dst, const Regs& r, int tid) const {
        if (tid < 256) { float s = 0.f;
#pragma unroll
            for (int j = 0; j < NP / 4; ++j) s += (r.v[j][0] + r.v[j][1]) + (r.v[j][2] + r.v[j][3]);
            dst[tid] = 1.0f / sqrtf(s * inv_n + EPS); } }
};
struct RsGather {
    const float* rstd; const int* list;
    struct Regs { float v; };
    __device__ __forceinline__ Regs pre(const Unit& u, int tid) const { Regs r; r.v = (tid < 256 && tid < u.gn) ? rstd[list[u.lo + tid]] : 0.f; return r; }
    __device__ __forceinline__ Regs pre_tok(int tok, const Unit& u, int tid) const { Regs r; r.v = (tid < 256 && tid < u.gn) ? rstd[tok] : 0.f; return r; }
    __device__ __forceinline__ void post(PG8_LAS float* dst, const Regs& r, int tid) const { if (tid < 256) dst[tid] = r.v; }
};

__device__ __forceinline__ void st16(bf16_t* base, size_t off, v4u w) {
#ifdef NO_WT_STORES
    *(v4u*)(base + off) = w;
#else
    __builtin_amdgcn_raw_buffer_store_b128(w, __builtin_amdgcn_make_buffer_rsrc((void*)base, 0, 0x7fffffff, 0x00020000), (int)(unsigned)(off * 2), 0, 16);
#endif
}
__device__ __forceinline__ void st_wt(float* p, float v) { __hip_atomic_store(p, v, __ATOMIC_RELAXED, __HIP_MEMORY_SCOPE_AGENT); }
#define EPI_ARGS const f32x4 (&acc)[2][2][4][2], const Unit& u, int wr, int wc, int fr, int fq, const PG8_LAS float* rs
#define EPI_FOR_ROWS _Pragma("unroll") for (int ai = 0; ai < 2; ++ai) _Pragma("unroll") for (int m = 0; m < 4; ++m)
#define EPI_LR (ai * HALF + wr * 64 + m * 16 + fr)

struct EpiIn {
    unsigned char* ws;
    __device__ __forceinline__ void operator()(EPI_ARGS) const {
        bf16_t* const CU = (bf16_t*)(ws + WS_CU); bf16_t* const ZB = (bf16_t*)(ws + WS_ZATT); bf16_t* const CQ = (bf16_t*)(ws + WS_CQ); bf16_t* const CKV = (bf16_t*)(ws + WS_CKV);
        bf16_t* const KB = (bf16_t*)(ws + WS_K); bf16_t* const S1 = (bf16_t*)(ws + WS_S1); bf16_t* const S2 = (bf16_t*)(ws + WS_S2);
        float* const SSQQ = (float*)(ws + WS_SSQQ); float* const SSQKV = (float*)(ws + WS_SSQKV); const float* const COS = (const float*)(ws + WS_COS); const float* const SIN = (const float*)(ws + WS_SIN);
        const int pn = u.pn, cw = wc * 32 + 8 * fq;
        if (pn < 4) {
            EPI_FOR_ROWS { const int lr = EPI_LR; const size_t row = (size_t)u.pm * BM + lr; const float s = rs[lr], s2 = s * s;
                const f32x4 a = acc[ai][0][m][0] * acc[ai][1][m][0] * s2, b = acc[ai][0][m][1] * acc[ai][1][m][1] * s2;
                st16(CU, row * DCONV + pn * 128 + cw, pack8(a, b)); }
        } else if (pn < 6) {
            EPI_FOR_ROWS { const int lr = EPI_LR; const size_t row = (size_t)u.pm * BM + lr; const float s = rs[lr];
#pragma unroll
                for (int bj = 0; bj < 2; ++bj) st16(ZB, row * 1024 + (pn - 4) * 256 + bj * HALF + cw, pack8(acc[ai][bj][m][0] * s, acc[ai][bj][m][1] * s)); }
        } else if (pn == 6 || pn == 8) {
            bf16_t* O = pn == 6 ? CQ : CKV; const int ld = pn == 6 ? QLORA : KVLORA; float* SQ = pn == 6 ? SSQQ : SSQKV; const int np = pn == 6 ? 8 : 4;
            EPI_FOR_ROWS { const int lr = EPI_LR; const size_t row = (size_t)u.pm * BM + lr; const float s = rs[lr]; float q = 0.f;
#pragma unroll
                for (int bj = 0; bj < 2; ++bj) { const f32x4 a = acc[ai][bj][m][0] * s, b = acc[ai][bj][m][1] * s;
                    q += (a[0] * a[0] + a[1] * a[1]) + (a[2] * a[2] + a[3] * a[3]) + (b[0] * b[0] + b[1] * b[1]) + (b[2] * b[2] + b[3] * b[3]);
                    st16(O, row * ld + bj * HALF + cw, pack8(a, b)); }
                q = xadd_16_32(q);
                if (fq == 0) SQ[row * np + wc] = q; }
        } else if (pn == 7) {
            EPI_FOR_ROWS { const int lr = EPI_LR; const size_t row = (size_t)u.pm * BM + lr; const float s = rs[lr];
                const f32x4 a = acc[ai][0][m][0] * s, b = acc[ai][0][m][1] * s;
                float q = (a[0] * a[0] + a[1] * a[1]) + (a[2] * a[2] + a[3] * a[3]) + (b[0] * b[0] + b[1] * b[1]) + (b[2] * b[2] + b[3] * b[3]);
                st16(CQ, row * QLORA + 256 + cw, pack8(a, b));
                q = xadd_16_32(q);
                if (fq == 0) SSQQ[row * 8 + 4 + wc] = q; }
            if (wc == 0) {
#pragma unroll
                for (int ai = 0; ai < 2; ++ai) { f32x4 cc[4], ss[4];
#pragma unroll
                    for (int m = 0; m < 4; ++m) { const size_t row = (size_t)u.pm * BM + EPI_LR; cc[m] = *(const f32x4*)(COS + row * 16 + 4 * fq); ss[m] = *(const f32x4*)(SIN + row * 16 + 4 * fq); }
#pragma unroll
                    for (int m = 0; m < 4; ++m) { const int lr = EPI_LR; const size_t row = (size_t)u.pm * BM + lr; const float s = rs[lr];
                        const f32x4 x1 = acc[ai][1][m][0] * s, x2 = acc[ai][1][m][1] * s;
                        const v4u w = pack8(x1 * cc[m] - x2 * ss[m], x2 * cc[m] + x1 * ss[m]);
#pragma unroll
                        for (int h = 0; h < NH; ++h) st16(KB, row * 768 + h * DQK + 64 + 8 * fq, w); }
                    asm volatile("" ::: "memory"); } }
        } else {
            const int t = pn - 9;
            EPI_FOR_ROWS { const int lr = EPI_LR; const size_t row = (size_t)u.pm * BM + lr; const float s = rs[lr]; f32x4 rr[2], ss[2];
#pragma unroll
                for (int n = 0; n < 2; ++n) { const f32x4 gc = acc[ai][0][m][n] * s, gm = acc[ai][1][m][n] * s; f32x4 r, s2;
#pragma unroll
                    for (int j = 0; j < 4; ++j) { const float ec = __builtin_amdgcn_exp2f(-1.4426950408889634f * gc[j]), em = __builtin_amdgcn_exp2f(-1.4426950408889634f * gm[j]);
                        s2[j] = __builtin_amdgcn_rcpf(1.0f + em); r[j] = (1.0f + em) * __builtin_amdgcn_rcpf(1.0f + ec); }
                    rr[n] = r; ss[n] = s2; }
                st16(S1, row * 1024 + t * 128 + cw, pack8(rr[0], rr[1])); st16(S2, row * 1024 + t * 128 + cw, pack8(ss[0], ss[1])); }
        }
    }
};
struct EpiQ {
    bf16_t* Q; const float *COS, *SIN, *SSQ;
    __device__ __forceinline__ void operator()(EPI_ARGS) const {
        const int cw = wc * 32 + 8 * fq; float sv[2][4];
        { f32x4 q0[2][4], q1[2][4];
          EPI_FOR_ROWS { const size_t row = (size_t)u.pm * BM + EPI_LR; q0[ai][m] = *(const f32x4*)(SSQ + row * 8); q1[ai][m] = *(const f32x4*)(SSQ + row * 8 + 4); }
          EPI_FOR_ROWS sv[ai][m] = QSCALE / sqrtf((((q0[ai][m][0] + q0[ai][m][1]) + (q0[ai][m][2] + q0[ai][m][3])) + ((q1[ai][m][0] + q1[ai][m][1]) + (q1[ai][m][2] + q1[ai][m][3]))) * (1.0f / QLORA) + EPS); }
        asm volatile("" ::: "memory");
        const int rb = (u.pn * 8 + wc) % 3;
#pragma unroll
        for (int g2 = 0; g2 < 4; ++g2) { f32x4 cc[2], ss[2];
            if (rb != 0) {
#pragma unroll
                for (int j = 0; j < 2; ++j) { const int ai = g2 >> 1, m = (g2 & 1) * 2 + j; const size_t row = (size_t)u.pm * BM + EPI_LR; cc[j] = *(const f32x4*)(COS + row * 16 + 4 * fq); ss[j] = *(const f32x4*)(SIN + row * 16 + 4 * fq); } }
#pragma unroll
            for (int j = 0; j < 2; ++j) { const int ai = g2 >> 1, m = (g2 & 1) * 2 + j; const int lr = EPI_LR; const size_t row = (size_t)u.pm * BM + lr; const float s = sv[ai][m];
#pragma unroll
                for (int bj = 0; bj < 2; ++bj) { f32x4 a = acc[ai][bj][m][0] * s, b = acc[ai][bj][m][1] * s;
                    if ((rb + bj) % 3 == 2) { const f32x4 x1 = a, x2 = b; a = x1 * cc[j] - x2 * ss[j]; b = x2 * cc[j] + x1 * ss[j]; }
                    st16(Q, row * 768 + u.pn * 256 + bj * HALF + cw, pack8(a, b)); } }
            asm volatile("" ::: "memory"); }
    }
};
struct EpiKV {
    bf16_t *KB, *VB; const float* SSQ;
    __device__ __forceinline__ void operator()(EPI_ARGS) const {
        float sv[2][4];
        { f32x4 q0[2][4];
          EPI_FOR_ROWS q0[ai][m] = *(const f32x4*)(SSQ + ((size_t)u.pm * BM + EPI_LR) * 4);
          EPI_FOR_ROWS sv[ai][m] = 1.0f / sqrtf(((q0[ai][m][0] + q0[ai][m][1]) + (q0[ai][m][2] + q0[ai][m][3])) * (1.0f / KVLORA) + EPS); }
        EPI_FOR_ROWS { const int lr = EPI_LR; const size_t row = (size_t)u.pm * BM + lr; const float s = sv[ai][m];
#pragma unroll
            for (int bj = 0; bj < 2; ++bj) { const int h = u.pn * 2 + bj; const v4u w = pack8(acc[ai][bj][m][0] * s, acc[ai][bj][m][1] * s);
                if (wc < 2) st16(KB, row * 768 + h * DQK + wc * 32 + 8 * fq, w); else st16(VB, row * 512 + h * DVH + (wc - 2) * 32 + 8 * fq, w); } }
    }
};
struct EpiMerge {
    static constexpr int HOOK_T = 8;
    const bf16_t* Rm; const bf16_t* S2; bf16_t* O;
    __device__ __forceinline__ void mid(f32x4 (&acc)[2][2][4][2], const Unit& u, int wr, int wc, int fr, int fq) const {
        const int cw = wc * 32 + 8 * fq; v4u g[2][4][2];
        EPI_FOR_ROWS {
#pragma unroll
            for (int bj = 0; bj < 2; ++bj) g[ai][m][bj] = *(const v4u*)(Rm + ((size_t)u.pm * BM + EPI_LR) * 1024 + u.pn * 256 + bj * HALF + cw); }
        EPI_FOR_ROWS {
#pragma unroll
            for (int bj = 0; bj < 2; ++bj) { f32x4 ga, gb; unpack8(g[ai][m][bj], ga, gb); acc[ai][bj][m][0] *= ga; acc[ai][bj][m][1] *= gb; } }
    }
    __device__ __forceinline__ void operator()(EPI_ARGS) const {
        const int cw = wc * 32 + 8 * fq; v4u g[2][4][2];
        EPI_FOR_ROWS {
#pragma unroll
            for (int bj = 0; bj < 2; ++bj) g[ai][m][bj] = *(const v4u*)(S2 + ((size_t)u.pm * BM + EPI_LR) * 1024 + u.pn * 256 + bj * HALF + cw); }
        EPI_FOR_ROWS {
#pragma unroll
            for (int bj = 0; bj < 2; ++bj) { f32x4 ga, gb; unpack8(g[ai][m][bj], ga, gb);
                st16(O, ((size_t)u.pm * BM + EPI_LR) * 1024 + u.pn * 256 + bj * HALF + cw, pack8(acc[ai][bj][m][0] * ga, acc[ai][bj][m][1] * gb)); } }
    }
};
template <bool SIG> struct EpiRes {
    const void* XR; bf16_t* XO; float* PART;
    __device__ __forceinline__ void operator()(EPI_ARGS) const {
        const int cw = wc * 32 + 8 * fq;
#pragma unroll
        for (int ai = 0; ai < 2; ++ai) {
            f32x4 xa[4][2], xb[4][2];
#pragma unroll
            for (int m = 0; m < 4; ++m)
#pragma unroll
                for (int bj = 0; bj < 2; ++bj) { const size_t off = ((size_t)u.pm * BM + EPI_LR) * 1024 + u.pn * 256 + bj * HALF + cw;
                    unpack8(*(const v4u*)((const bf16_t*)XR + off), xa[m][bj], xb[m][bj]); }
#pragma unroll
            for (int m = 0; m < 4; ++m) { const size_t row = (size_t)u.pm * BM + EPI_LR; float q = 0.f;
#pragma unroll
                for (int bj = 0; bj < 2; ++bj) { const size_t off = row * 1024 + u.pn * 256 + bj * HALF + cw;
                    const f32x4 a = xa[m][bj] + acc[ai][bj][m][0], b = xb[m][bj] + acc[ai][bj][m][1];
                    q += (a[0] * a[0] + a[1] * a[1]) + (a[2] * a[2] + a[3] * a[3]) + (b[0] * b[0] + b[1] * b[1]) + (b[2] * b[2] + b[3] * b[3]);
                    st16(XO, off, pack8(a, b)); }
                q = xadd_16_32(q);
                if (fq == 0) PART[row * 16 + u.pn * 4 + wc] = q; }
            asm volatile("" ::: "memory");
        }
        if constexpr (SIG) { asm volatile("s_waitcnt vmcnt(0)" ::: "memory");
            if ((fr | fq) == 0) (void)__hip_atomic_fetch_add((unsigned*)((unsigned char*)PART - WS_PART + WS_CTL) + CW_RDY2, 1u, __ATOMIC_RELAXED, __HIP_MEMORY_SCOPE_AGENT); }
    }
};
template <bool SIG> struct EpiUpT {
    bf16_t* H; int ldh; unsigned* rdy;
    __device__ __forceinline__ void operator()(EPI_ARGS) const {
        const int cw = wc * 32 + 8 * fq;
        EPI_FOR_ROWS { const int lr = EPI_LR; const size_t row = (size_t)u.pm * BM + lr; const float s = rs[lr];
            f32x4 o[2];
#pragma unroll
            for (int n = 0; n < 2; ++n) { const f32x4 g = acc[ai][0][m][n] * s, up = acc[ai][1][m][n] * s;
#pragma unroll
                for (int j = 0; j < 4; ++j) o[n][j] = g[j] * sigmoidf_(g[j]) * up[j]; }
            st16(H, row * ldh + u.pn * 128 + cw, pack8(o[0], o[1])); }
        if constexpr (SIG) { if (u.pm < 8) {
            asm volatile("s_waitcnt vmcnt(0)" ::: "memory");
            if ((fr | fq) == 0) (void)__hip_atomic_fetch_add(rdy, 1u, __ATOMIC_RELAXED, __HIP_MEMORY_SCOPE_AGENT); } }
    }
};
typedef EpiUpT<false> EpiUp;
struct EpiY {
    bf16_t* Y;
    __device__ __forceinline__ void operator()(EPI_ARGS) const {
        const int cw = wc * 32 + 8 * fq;
        EPI_FOR_ROWS { const int lr = EPI_LR; const size_t row = (size_t)u.pm * BM + lr;
#pragma unroll
            for (int bj = 0; bj < 2; ++bj) st16(Y, row * 1024 + u.pn * 256 + bj * HALF + cw, pack8(acc[ai][bj][m][0], acc[ai][bj][m][1])); }
    }
};

template <class T, class = void> struct hook_t { static constexpr int v = 0; };
template <class T> struct hook_t<T, decltype((void)T::HOOK_T)> { static constexpr int v = T::HOOK_T; };
template <class Epi, class Sched, class RS, bool GATHER, bool ALIGN_EPI>
__device__ __forceinline__ void gemm_phase(int wave, PG8_LAS unsigned char* lds, PG8_LAS float* rsb, const Gemm g, const Sched& S, const Epi& E, const RS& RSC, const int* glist, int gn) {
    const int lane_ = fresh_lane(); int wid_ = wave; asm volatile("" : "+s"(wid_));
    const int wid = wid_, lane = lane_, tid = wid * 64 + lane, wr = wid >> 2, wc = wid & 3, fr = lane & 15, fq = lane >> 4;
    const int K = g.K, nt = K / BK, lda = g.lda;
    const __amdgpu_buffer_rsrc_t rA = __builtin_amdgcn_make_buffer_rsrc((void*)g.A, 0, 0x7fffffff, 0x00020000);
    const __amdgpu_buffer_rsrc_t rB = __builtin_amdgcn_make_buffer_rsrc((void*)g.Bt, 0, 0x7fffffff, 0x00020000);
    unsigned vB[2];
#pragma unroll
    for (int i = 0; i < 2; ++i) { int R_, C_; stage_rc(tid * 16 + i * 8192, R_, C_); const int Rb = (R_ & ~31) + perm32(R_ & 31); vB[i] = (unsigned)(Rb * K + C_) * 2u; }
    const unsigned kstep = (unsigned)(BK * 2);
    const unsigned hstepB = (unsigned)HALF * K * 2, tstepB = 2 * hstepB;
    const unsigned hstepA = (unsigned)HALF * lda * 2, tstepA = 2 * hstepA;
    const unsigned ldsw = (unsigned)wid * 1024u;
    const int aoff = lds_byte(wr * 64 + fr, fq * 8), boff = lds_byte(wc * 32 + fr, fq * 8);
#define PG8_SETA(v, un) do { _Pragma("unroll") for (int i_ = 0; i_ < 2; ++i_) { int R_, C_; stage_rc(tid * 16 + i_ * 8192, R_, C_); \
        if constexpr (GATHER) { _Pragma("unroll") for (int h_ = 0; h_ < 2; ++h_) { const int r_ = h_ * HALF + R_; const int tok_ = r_ < (un).gn ? glist[(un).lo + r_] : 0; v[h_][i_] = (unsigned)(tok_ * lda + C_) * 2u; } } \
        else { v[0][i_] = (unsigned)(R_ * lda + C_) * 2u; } } } while (0)
#define PG8_H1(off) (GATHER ? (off) : (off) + hstepA)
#define PG8_LDTOK(tk_, un) do { _Pragma("unroll") for (int i_ = 0; i_ < 2; ++i_) { int R_, C_; stage_rc(tid * 16 + i_ * 8192, R_, C_); (void)C_; \
        _Pragma("unroll") for (int h_ = 0; h_ < 2; ++h_) { const int r_ = h_ * HALF + R_; tk_[h_][i_] = r_ < (un).gn ? glist[(un).lo + r_] : 0; } } } while (0)
#define PG8_TOK2V(v, tk_) do { _Pragma("unroll") for (int i_ = 0; i_ < 2; ++i_) { int R_, C_; stage_rc(tid * 16 + i_ * 8192, R_, C_); (void)R_; \
        _Pragma("unroll") for (int h_ = 0; h_ < 2; ++h_) v[h_][i_] = (unsigned)(tk_[h_][i_] * lda + C_) * 2u; } } while (0)
#define PG8_SA(b, h) (((b) * 2 + (h)) * HTB)
#define PG8_SB(b, h) ((4 + (b) * 2 + (h)) * HTB)
#define PG8_STG(bufoff, rsrc, soff, o0, o1) do { \
        __builtin_amdgcn_raw_ptr_buffer_load_lds(rsrc, (PG8_LAS void*)(lds + (bufoff) + ldsw), 16, (int)(o0), (int)(soff), 0, 0); \
        __builtin_amdgcn_raw_ptr_buffer_load_lds(rsrc, (PG8_LAS void*)(lds + (bufoff) + ldsw + 8192), 16, (int)(o1), (int)(soff), 0, 0); } while (0)
#define PG8_LDA(dst, b, h) do { _Pragma("unroll") for (int m = 0; m < 4; ++m) _Pragma("unroll") for (int k = 0; k < 2; ++k) dst[m][k] = *(const PG8_LAS bf16x8*)(lds + PG8_SA(b, h) + aoff + m * 2048 + k * 1024); } while (0)
#define PG8_LDB(dst, b, h) do { _Pragma("unroll") for (int n = 0; n < 2; ++n) _Pragma("unroll") for (int k = 0; k < 2; ++k) dst[n][k] = *(const PG8_LAS bf16x8*)(lds + PG8_SB(b, h) + boff + n * 2048 + k * 1024); } while (0)
#define PG8_MMA(ai, bj, At, Bt) do { __builtin_amdgcn_s_setprio(1); _Pragma("unroll") for (int m = 0; m < 4; ++m) _Pragma("unroll") for (int n = 0; n < 2; ++n) _Pragma("unroll") for (int k = 0; k < 2; ++k) \
        acc[ai][bj][m][n] = __builtin_amdgcn_mfma_f32_16x16x32_bf16(Bt[n][k], At[m][k], acc[ai][bj][m][n], 0, 0, 0); __builtin_amdgcn_s_setprio(0); } while (0)
#define PG8_WAIT_V(n) asm volatile("s_waitcnt vmcnt(" #n ")" ::: "memory")
#define PG8_WAIT_L(n) asm volatile("s_waitcnt lgkmcnt(" #n ")" ::: "memory")
#define PG8_BAR __builtin_amdgcn_s_barrier()
#define PG8_SCHED __builtin_amdgcn_sched_barrier(0)
    Unit cur, nxt, nx2; int ui = 0; bool hn = false; int tk[GATHER ? 2 : 1][2]; int tkr = 0, tkru = 0;
    if (!S.next(0, cur)) return;
    f32x4 acc[2][2][4][2];
#pragma unroll
    for (int a = 0; a < 2; ++a)
#pragma unroll
        for (int b = 0; b < 2; ++b)
#pragma unroll
            for (int m = 0; m < 4; ++m)
#pragma unroll
                for (int n = 0; n < 2; ++n) acc[a][b][m][n] = (f32x4){0.f, 0.f, 0.f, 0.f};
    bf16x8 At[4][2], B0[2][2], B1[2][2];
    unsigned vA[GATHER ? 2 : 1][2], vN[GATHER ? 2 : 1][2];
    PG8_SETA(vA, cur);
    unsigned cA = GATHER ? 0u : (unsigned)cur.pm * tstepA, cB = (unsigned)cur.pn * tstepB + cur.bo;
    { const auto r0_ = RSC.pre(cur, tid); RSC.post(rsb, r0_, tid); }
    PG8_STG(PG8_SB(0, 0), rB, cB, vB[0], vB[1]); PG8_STG(PG8_SB(0, 1), rB, cB + hstepB, vB[0], vB[1]); PG8_STG(PG8_SA(0, 0), rA, cA, vA[0][0], vA[0][1]); PG8_STG(PG8_SA(0, 1), rA, PG8_H1(cA), vA[GATHER ? 1 : 0][0], vA[GATHER ? 1 : 0][1]);
    if (wr == 1) PG8_BAR;
    PG8_WAIT_V(2); PG8_BAR;
    PG8_STG(PG8_SB(1, 0), rB, cB + kstep, vB[0], vB[1]); PG8_STG(PG8_SA(1, 0), rA, cA + kstep, vA[0][0], vA[0][1]); PG8_STG(PG8_SB(1, 1), rB, cB + hstepB + kstep, vB[0], vB[1]);
    PG8_WAIT_V(6); PG8_BAR;
    if constexpr (GATHER) { hn = S.next(1, nxt); if (hn) { PG8_LDTOK(tk, nxt); tkr = (tid < 256 && tid < nxt.gn) ? glist[nxt.lo + tid] : 0; } }
    for (;;) {
        bool has_next, hn2 = false;
        if constexpr (GATHER) { has_next = hn; } else { has_next = S.next(ui + 1, nxt); }
        const unsigned nA = has_next ? (GATHER ? 0u : (unsigned)nxt.pm * tstepA) : cA, nB = has_next ? (unsigned)nxt.pn * tstepB + nxt.bo : cB;
        if constexpr (GATHER) { tkru = tkr; if (has_next) { PG8_TOK2V(vN, tk); } else {
#pragma unroll
            for (int h = 0; h < 2; ++h)
#pragma unroll
                for (int i = 0; i < 2; ++i) vN[h][i] = vA[h][i]; }
            hn2 = has_next && S.next(ui + 2, nx2); if (hn2) { PG8_LDTOK(tk, nx2); tkr = (tid < 256 && tid < nx2.gn) ? glist[nx2.lo + tid] : 0; } }
        typename RS::Regs rnext{};
        for (int t = 0; t < nt; t += 2) {
            const bool last = (t == nt - 2);
            if (last && has_next) { if constexpr (GATHER) rnext = RSC.pre_tok(tkru, nxt, wid * 64 + fresh_lane()); else rnext = RSC.pre(nxt, wid * 64 + fresh_lane()); }
            const unsigned a1 = cA + (unsigned)(t + 1) * kstep;
            const unsigned a2 = last ? nA : cA + (unsigned)(t + 2) * kstep, b2 = last ? nB : cB + (unsigned)(t + 2) * kstep;
            const unsigned a3 = a2 + kstep, b3 = b2 + kstep;
            unsigned x00 = vA[0][0], x01 = vA[0][1], x10 = vA[GATHER ? 1 : 0][0], x11 = vA[GATHER ? 1 : 0][1];
            if constexpr (GATHER) { if (last) { x00 = vN[0][0]; x01 = vN[0][1]; x10 = vN[1][0]; x11 = vN[1][1]; } }
            if constexpr (hook_t<Epi>::v > 0) { if (t == hook_t<Epi>::v) { const int l_m = fresh_lane(); E.mid(acc, cur, wr, wc, l_m & 15, l_m >> 4); } }
            PG8_LDB(B0, 0, 0); PG8_LDB(B1, 0, 1); PG8_SCHED; PG8_LDA(At, 0, 0); PG8_STG(PG8_SA(1, 1), rA, PG8_H1(a1), vA[GATHER ? 1 : 0][0], vA[GATHER ? 1 : 0][1]);
            PG8_WAIT_V(8); PG8_WAIT_L(0); PG8_BAR; PG8_MMA(0, 0, At, B0); PG8_MMA(0, 1, At, B1); PG8_BAR; PG8_SCHED;
            PG8_LDA(At, 0, 1); PG8_STG(PG8_SB(0, 0), rB, b2, vB[0], vB[1]); PG8_STG(PG8_SB(0, 1), rB, b2 + hstepB, vB[0], vB[1]); PG8_STG(PG8_SA(0, 0), rA, a2, x00, x01);
            PG8_WAIT_V(8); PG8_WAIT_L(0); PG8_BAR; PG8_MMA(1, 0, At, B0); PG8_MMA(1, 1, At, B1); PG8_BAR; PG8_SCHED;
            PG8_LDB(B0, 1, 0); PG8_LDB(B1, 1, 1); PG8_SCHED; PG8_LDA(At, 1, 0); PG8_STG(PG8_SA(0, 1), rA, PG8_H1(a2), x10, x11);
            PG8_WAIT_V(8); PG8_WAIT_L(0); PG8_BAR; PG8_MMA(0, 0, At, B0); PG8_MMA(0, 1, At, B1); PG8_BAR; PG8_SCHED;
            PG8_LDA(At, 1, 1); PG8_STG(PG8_SB(1, 0), rB, b3, vB[0], vB[1]); PG8_STG(PG8_SB(1, 1), rB, b3 + hstepB, vB[0], vB[1]); PG8_STG(PG8_SA(1, 0), rA, a3, x00, x01);
            PG8_WAIT_V(8); PG8_WAIT_L(0); PG8_BAR; PG8_MMA(1, 0, At, B0); PG8_MMA(1, 1, At, B1); PG8_BAR; PG8_SCHED;
        }
        if constexpr (ALIGN_EPI) { if (wr == 0) PG8_BAR; }
        { const int l_e = fresh_lane();
          E(acc, cur, wr, wc, l_e & 15, l_e >> 4, (const PG8_LAS float*)(rsb + (ui & 1) * 256));
          if (has_next) RSC.post(rsb + ((ui + 1) & 1) * 256, rnext, wid * 64 + l_e); }
        if (!has_next) break;
#pragma unroll
        for (int a = 0; a < 2; ++a)
#pragma unroll
            for (int b = 0; b < 2; ++b)
#pragma unroll
                for (int m = 0; m < 4; ++m)
#pragma unroll
                    for (int n = 0; n < 2; ++n) acc[a][b][m][n] = (f32x4){0.f, 0.f, 0.f, 0.f};
        cur = nxt; cA = nA; cB = nB; ++ui;
        if constexpr (GATHER) { nxt = nx2; hn = hn2;
#pragma unroll
            for (int h = 0; h < 2; ++h)
#pragma unroll
                for (int i = 0; i < 2; ++i) vA[h][i] = vN[h][i]; }
        if constexpr (ALIGN_EPI) { if (wr == 1) PG8_BAR; }
    }
    PG8_WAIT_V(0);
    if constexpr (!ALIGN_EPI) { if (wr == 0) PG8_BAR; }
    PG8_BAR;
#undef PG8_SETA
#undef PG8_LDTOK
#undef PG8_TOK2V
#undef PG8_H1
#undef PG8_SA
#undef PG8_SB
#undef PG8_STG
#undef PG8_LDA
#undef PG8_LDB
#undef PG8_MMA
#undef PG8_WAIT_V
#undef PG8_WAIT_L
#undef PG8_BAR
#undef PG8_SCHED
}
}

namespace att {
using f32x16 = __attribute__((ext_vector_type(16))) float;
using s16x4 = __attribute__((ext_vector_type(4))) short;
typedef short v4i16_t __attribute__((ext_vector_type(4)));
constexpr int QBR = 256, KVBLK = 64, QP = 768, KP = 768, VP = 512, OP = 1024;
constexpr int KSLOT = 12288, VSLOT = 8192, NSLOT = 2;
constexpr int LDS_K = 0, LDS_V = NSLOT * KSLOT, LDS_WS = LDS_V + NSLOT * VSLOT, LDS_OST = LDS_WS + 8 * 256, LDS_BYTES = LDS_OST + 8 * 4096;
__device__ __forceinline__ int crow(int r, int hi) { return (r & 3) + 8 * (r >> 2) + 4 * hi; }
__device__ __forceinline__ void glds16(const void* gsrc, unsigned lds_dst) { unsigned keep;
    asm volatile("s_mov_b32 %0, m0\n\ts_mov_b32 m0, %2\n\ts_nop 0\n\tglobal_load_lds_dwordx4 %1, off\n\ts_mov_b32 m0, %0" : "=&s"(keep) : "v"(gsrc), "s"(lds_dst) : "memory"); }
__device__ __forceinline__ void cmask(f32x16& p0, f32x16& p1, int jb, int qrel, int hi) {
    const float NEG = -INFINITY; const int kb = 64 * jb + 4 * hi;
#pragma unroll
    for (int r = 0; r < 16; ++r) { const int kv = kb + (r & 3) + 8 * (r >> 2); if (kv > qrel) p0[r] = NEG; if (kv + 32 > qrel) p1[r] = NEG; }
}
typedef __attribute__((address_space(3))) const char* lds_cptr;
__device__ __forceinline__ void qkt6(f32x16& p0, f32x16& p1, lds_cptr kslot, const bf16x8* qr, int r32, int hi) {
    lds_cptr kb = kslot + hi * 1024 + r32 * 16;
    p0 = f32x16{}; p1 = f32x16{};
#pragma unroll
    for (int d0 = 0; d0 < 6; ++d0) {
        const bf16x8 b0 = *(const LAS bf16x8*)(kb + d0 * 2048);
        const bf16x8 b1 = *(const LAS bf16x8*)(kb + d0 * 2048 + 512);
        p0 = __builtin_amdgcn_mfma_f32_32x32x16_bf16(b0, qr[d0], p0, 0, 0, 0); p1 = __builtin_amdgcn_mfma_f32_32x32x16_bf16(b1, qr[d0], p1, 0, 0, 0); }
}
__device__ __forceinline__ float rowmax(const f32x16& p0, const f32x16& p1) {
    float a = fmaxf(p0[0], p1[0]);
#pragma unroll
    for (int r = 1; r < 16; ++r) a = fmaxf(a, fmaxf(p0[r], p1[r]));
    auto rr = __builtin_amdgcn_permlane32_swap(__float_as_uint(a), __float_as_uint(a), false, false);
    return fmaxf(__uint_as_float(rr[0]), __uint_as_float(rr[1]));
}
__device__ __forceinline__ s16x4 vtr(lds_cptr p) { return __builtin_bit_cast(s16x4, __builtin_amdgcn_ds_read_tr16_b64_v4i16((LAS v4i16_t*)p)); }
__device__ __forceinline__ void pv(f32x16* o, lds_cptr vp, bf16x8 pa0, bf16x8 pa1, bf16x8 pa2, bf16x8 pa3) {
#pragma unroll
    for (int d0 = 0; d0 < 2; ++d0) { s16x4 lo[4], hi[4];
#pragma unroll
        for (int ks = 0; ks < 4; ++ks) { lo[ks] = vtr(vp + d0 * 4096 + ks * 1024); hi[ks] = vtr(vp + d0 * 4096 + ks * 1024 + 512); }
#define PK(k) (bf16x8){lo[k][0], lo[k][1], lo[k][2], lo[k][3], hi[k][0], hi[k][1], hi[k][2], hi[k][3]}
        o[d0] = __builtin_amdgcn_mfma_f32_32x32x16_bf16(pa0, PK(0), o[d0], 0, 0, 0);
        o[d0] = __builtin_amdgcn_mfma_f32_32x32x16_bf16(pa1, PK(1), o[d0], 0, 0, 0);
        o[d0] = __builtin_amdgcn_mfma_f32_32x32x16_bf16(pa2, PK(2), o[d0], 0, 0, 0);
        o[d0] = __builtin_amdgcn_mfma_f32_32x32x16_bf16(pa3, PK(3), o[d0], 0, 0, 0);
#undef PK
    }
}
constexpr int NSV = 3;
constexpr int L2_K = 0, L2_V = 2 * KSLOT, L2_WS = L2_V + NSV * VSLOT, L2_OST = L2_WS + 8 * 256, L2_BYTES = L2_OST + 8 * 4096;
constexpr float THR = 8.0f;
struct AttnState { float mrun, l_reg; f32x16 o[2]; bf16x8 qr[6]; };
__device__ __forceinline__ void attn_load_q(AttnState& st, const bf16* Qw, int r32, int hi) {
#pragma unroll
    for (int d0 = 0; d0 < 6; ++d0) st.qr[d0] = *reinterpret_cast<const bf16x8*>(&Qw[(long)r32 * QP + d0 * 16 + hi * 8]);
    asm volatile("" : "+v"(st.qr[0]), "+v"(st.qr[1]), "+v"(st.qr[2]), "+v"(st.qr[3]), "+v"(st.qr[4]), "+v"(st.qr[5]));
    st.mrun = -INFINITY; st.l_reg = 0.f; st.o[0] = f32x16{}; st.o[1] = f32x16{};
}
__device__ __forceinline__ void attn_scores(AttnState& st, v4u (&pw)[4], lds_cptr kslot, int t, int NT, int qrel, int r32, int hi, LAS float* wsf) {
    f32x16 p0, p1;
    qkt6(p0, p1, kslot, st.qr, r32, hi);
    if (t >= NT - 4) cmask(p0, p1, t - (NT - 4), qrel, hi);
    const float rm = rowmax(p0, p1);
    if (__any(rm - st.mrun > THR)) {
        const float mn = fmaxf(st.mrun, rm); const float alpha = __builtin_amdgcn_exp2f(st.mrun - mn);
        if (hi == 0) wsf[r32] = alpha;
        asm volatile("s_waitcnt lgkmcnt(0)" ::: "memory");
#pragma unroll
        for (int d = 0; d < 2; ++d)
#pragma unroll
            for (int r = 0; r < 16; ++r) st.o[d][r] *= wsf[crow(r, hi)];
        st.l_reg *= alpha; st.mrun = mn;
    }
    const float mref = st.mrun; float sacc = 0.f;
#pragma unroll
    for (int r = 0; r < 16; ++r) { p0[r] = __builtin_amdgcn_exp2f(p0[r] - mref); p1[r] = __builtin_amdgcn_exp2f(p1[r] - mref); sacc += p0[r] + p1[r]; }
    st.l_reg += sacc;
#define PKW(P, B) cvt_pk_bf16(P[B], P[B + 1])
    pw[0] = (v4u){PKW(p0, 0), PKW(p0, 2), PKW(p0, 4), PKW(p0, 6)}; pw[1] = (v4u){PKW(p0, 8), PKW(p0, 10), PKW(p0, 12), PKW(p0, 14)};
    pw[2] = (v4u){PKW(p1, 0), PKW(p1, 2), PKW(p1, 4), PKW(p1, 6)}; pw[3] = (v4u){PKW(p1, 8), PKW(p1, 10), PKW(p1, 12), PKW(p1, 14)};
#undef PKW
}
__device__ __forceinline__ void attn_pv(AttnState& st, const v4u (&pw)[4], lds_cptr vp) {
    pv(st.o, vp, __builtin_bit_cast(bf16x8, pw[0]), __builtin_bit_cast(bf16x8, pw[1]), __builtin_bit_cast(bf16x8, pw[2]), __builtin_bit_cast(bf16x8, pw[3]));
}
__device__ __forceinline__ void attn_store_o(AttnState& st, bf16* Ow, LAS float* wsf, LAS bf16* stg, int lane, int r32, int hi) {
    float l = st.l_reg;
    { auto rr = __builtin_amdgcn_permlane32_swap(__float_as_uint(l), __float_as_uint(l), false, false); l = __uint_as_float(rr[0]) + __uint_as_float(rr[1]); }
    if (hi == 0) wsf[32 + r32] = l;
    asm volatile("s_waitcnt lgkmcnt(0)" ::: "memory");
    float rli[16];
#pragma unroll
    for (int r = 0; r < 16; ++r) rli[r] = __builtin_amdgcn_rcpf(wsf[32 + crow(r, hi)]);
#pragma unroll
    for (int r = 0; r < 16; ++r) { const int orow = crow(r, hi);
#pragma unroll
        for (int d0 = 0; d0 < 2; ++d0) stg[orow * 64 + d0 * 32 + r32] = (bf16)(cvt_pk_bf16(st.o[d0][r] * rli[r], 0.f) & 0xffffu); }
    asm volatile("s_waitcnt lgkmcnt(0)" ::: "memory");
#pragma unroll
    for (int i = 0; i < 4; ++i) { const int row = i * 8 + (lane >> 3), ch = lane & 7; const v4u v = *(const LAS v4u*)(stg + row * 64 + ch * 8); *(v4u*)(Ow + (long)row * OP + ch * 8) = v; }
    asm volatile("s_waitcnt lgkmcnt(0)" ::: "memory");
}
template <int HALFB>
__device__ __forceinline__ void attn_pair_loop(int wid, int lane, int b, int h, int qbA, int qbB, const bf16* Q, const bf16* K, const bf16* V, bf16* O, char* shm) {
    const int r32 = lane & 31, hi = lane >> 5;
    const long rowbase = (long)b * SEQ;
    const bf16* Kh = K + rowbase * KP + h * DQK; const bf16* Vh = V + rowbase * VP + h * DVH;
    const unsigned lds0 = (unsigned)(uintptr_t)shm;
    const lds_cptr shm3 = (lds_cptr)shm;
    LAS float* wsf = (LAS float*)(shm3 + L2_WS) + wid * 64;
    LAS bf16* stg = (LAS bf16*)(shm3 + L2_OST) + wid * 2048;
    const bf16* ksrc0 = Kh + (long)lane * KP + wid * 8;
    const bf16* ksrc1 = Kh + (long)lane * KP + (8 + (wid & 3)) * 8;
    const bf16* vsrc = Vh + (long)(16 * (wid & 3) + (lane >> 2)) * VP + (wid >> 2) * 32 + (lane & 3) * 8;
    const unsigned kdst0 = lds0 + L2_K + wid * 1024, kdst1 = lds0 + L2_K + (8 + (wid & 3)) * 1024, vdst = lds0 + L2_V + wid * 1024;
#define DMA_KV(t, ks, vs) do { glds16(ksrc0 + (long)(t) * KVBLK * KP, (unsigned)__builtin_amdgcn_readfirstlane(kdst0 + (ks) * KSLOT)); \
        if (wid < 4) glds16(ksrc1 + (long)(t) * KVBLK * KP, (unsigned)__builtin_amdgcn_readfirstlane(kdst1 + (ks) * KSLOT)); \
        glds16(vsrc + (long)(t) * KVBLK * VP, (unsigned)__builtin_amdgcn_readfirstlane(vdst + (vs) * VSLOT)); } while (0)
    const lds_cptr vp0 = shm3 + L2_V + ((lane >> 4) & 1) * 32 + (lane & 3) * 8 + (4 * hi + ((lane & 15) >> 2)) * 64;
    const int q0A = qbA * QBR, q0B = qbB * QBR, NTa = (q0A + QBR) / KVBLK, NTb = (q0B + QBR) / KVBLK, G = NTa + NTb;
    const int qrel = wid * 32 + r32;
    const bf16* QwA = Q + (rowbase + q0A + wid * 32) * QP + h * DQK; const bf16* QwB = Q + (rowbase + q0B + wid * 32) * QP + h * DQK;
    bf16* OwA = O + (rowbase + q0A + wid * 32) * OP + 512 + h * DVH; bf16* OwB = O + (rowbase + q0B + wid * 32) * OP + 512 + h * DVH;
    DMA_KV(0, 0, 0);
    AttnState st; attn_load_q(st, QwA, r32, hi);
    v4u pw[4]; pw[0] = pw[1] = pw[2] = pw[3] = (v4u){0u, 0u, 0u, 0u};
    asm volatile("s_waitcnt vmcnt(0) lgkmcnt(0)\n\ts_barrier" ::: "memory");
    int vs = 0;
    for (int g = 0; g < G; ++g) {
        const int ks = g & 1, vsn = (vs == NSV - 1) ? 0 : vs + 1, vsp = (vs == 0) ? NSV - 1 : vs - 1;
        const bool inB = g >= NTa; const int t = inB ? g - NTa : g, NT = inB ? NTb : NTa;
        if (g + 1 < G) { const int tn = (g + 1 >= NTa) ? g + 1 - NTa : g + 1; DMA_KV(tn, ks ^ 1, vsn); }
        if (HALFB) {
            if (g > 0) { attn_pv(st, pw, vp0 + vsp * VSLOT);
                if (g == NTa) { attn_store_o(st, OwA, wsf, stg, lane, r32, hi); attn_load_q(st, QwB, r32, hi); } }
            attn_scores(st, pw, shm3 + L2_K + ks * KSLOT, t, NT, qrel, r32, hi, wsf);
        } else {
            attn_scores(st, pw, shm3 + L2_K + ks * KSLOT, t, NT, qrel, r32, hi, wsf);
            attn_pv(st, pw, vp0 + vs * VSLOT);
            if (g == NTa - 1) { attn_store_o(st, OwA, wsf, stg, lane, r32, hi); attn_load_q(st, QwB, r32, hi); }
        }
        asm volatile("s_waitcnt vmcnt(0) lgkmcnt(0)\n\ts_barrier" ::: "memory");
        vs = vsn;
    }
    if (HALFB) attn_pv(st, pw, vp0 + ((vs == 0) ? NSV - 1 : vs - 1) * VSLOT);
    attn_store_o(st, OwB, wsf, stg, lane, r32, hi);
    asm volatile("s_waitcnt vmcnt(0) lgkmcnt(0)\n\ts_barrier" ::: "memory");
#undef DMA_KV
}
__device__ __forceinline__ void attn_pair(int wave, int b, int h, int qbA, int qbB, const bf16* Q, const bf16* K, const bf16* V, bf16* O, char* shm) {
    const int lane = fresh_lane(); int wid_ = wave; asm volatile("" : "+s"(wid_));
    if (wid_ < 4) attn_pair_loop<0>(wid_, lane, b, h, qbA, qbB, Q, K, V, O, shm);
    else attn_pair_loop<1>(wid_, lane, b, h, qbA, qbB, Q, K, V, O, shm);
}
}

namespace att2 {
using att::f32x16; using att::s16x4; using att::lds_cptr; using att::crow; using att::glds16; using att::cmask; using att::vtr;
constexpr int QBR = 256, KVBLK = 64, QP = 768, KP = 768, VP = 512, OP = 1024;
constexpr int KSLOT = 12288, VSLOT = 8192, NKS = 4, NVS = 3;
constexpr int LDS_K = 0, LDS_V = NKS * KSLOT, LDS_WS = LDS_V + NVS * VSLOT, LDS_OST = LDS_WS + 8 * 256, LDS_BYTES = LDS_OST + 8 * 4096;
__device__ __forceinline__ void glds16s(unsigned voff, const void* sbase, unsigned lds_dst) { unsigned keep;
    asm volatile("s_mov_b32 %0, m0\n\ts_mov_b32 m0, %3\n\ts_nop 0\n\tglobal_load_lds_dwordx4 %1, %2\n\ts_mov_b32 m0, %0" : "=&s"(keep) : "v"(voff), "s"(sbase), "s"(lds_dst) : "memory"); }
#define SBAR() __builtin_amdgcn_sched_barrier(0)
#define WAIT_BAR(N) asm volatile("s_waitcnt vmcnt(" #N ") lgkmcnt(0)\n\ts_barrier" ::: "memory")
__device__ __forceinline__ float max3f(float a, float b, float c) { float r; asm("v_max3_f32 %0, %1, %2, %3" : "=v"(r) : "v"(a), "v"(b), "v"(c)); return r; }
__device__ __forceinline__ float max2f(float a, float b) { float r; asm("v_max_f32_e32 %0, %1, %2" : "=v"(r) : "v"(a), "v"(b)); return r; }
__device__ __forceinline__ float fadd_s(float a, float b) { float r; asm("v_add_f32_e32 %0, %1, %2" : "=v"(r) : "v"(a), "v"(b)); return r; }
__device__ __forceinline__ float fsub_s(float a, float b) { float r; asm("v_sub_f32_e32 %0, %1, %2" : "=v"(r) : "v"(a), "v"(b)); return r; }
__device__ __forceinline__ void qkt(f32x16& p0, f32x16& p1, lds_cptr kslot, const bf16x8* qr, const f32x16& negm, int r32, int hi) {
    lds_cptr kb = kslot + hi * 1024 + r32 * 16;
#pragma unroll
    for (int d0 = 0; d0 < 6; ++d0) {
        const bf16x8 b0 = *(const LAS bf16x8*)(kb + d0 * 2048);
        const bf16x8 b1 = *(const LAS bf16x8*)(kb + d0 * 2048 + 512);
        if (d0 == 0) { p0 = __builtin_amdgcn_mfma_f32_32x32x16_bf16(b0, qr[0], negm, 0, 0, 0); p1 = __builtin_amdgcn_mfma_f32_32x32x16_bf16(b1, qr[0], negm, 0, 0, 0); }
        else { p0 = __builtin_amdgcn_mfma_f32_32x32x16_bf16(b0, qr[d0], p0, 0, 0, 0); p1 = __builtin_amdgcn_mfma_f32_32x32x16_bf16(b1, qr[d0], p1, 0, 0, 0); } }
}
__device__ __forceinline__ void kload2(bf16x8* kf, lds_cptr kp, int j) { kf[2 * j] = *(const LAS bf16x8*)(kp + j * 2048); kf[2 * j + 1] = *(const LAS bf16x8*)(kp + j * 2048 + 512); }
__device__ __forceinline__ float rowmax(const f32x16& p0, const f32x16& p1) {
    float a = max3f(p0[0], p0[1], p1[0]), b = max3f(p0[2], p0[3], p1[1]); a = max3f(a, p1[2], p1[3]);
#pragma unroll
    for (int r = 4; r < 16; r += 4) { a = max3f(a, p0[r], p0[r + 1]); b = max3f(b, p0[r + 2], p0[r + 3]); a = max3f(a, p1[r], p1[r + 1]); b = max3f(b, p1[r + 2], p1[r + 3]); }
    const float m = max2f(a, b);
    auto rr = __builtin_amdgcn_permlane32_swap(__float_as_uint(m), __float_as_uint(m), false, false);
    return max2f(__uint_as_float(rr[0]), __uint_as_float(rr[1]));
}
__device__ __forceinline__ void pv(f32x16* o, int vb, bf16x8 pa0, bf16x8 pa1, bf16x8 pa2, bf16x8 pa3) {
#pragma unroll
    for (int d0 = 0; d0 < 2; ++d0) { s16x4 lo[4], hi[4];
#pragma unroll
        for (int ks = 0; ks < 4; ++ks) {
            asm volatile("ds_read_b64_tr_b16 %0,%1 offset:%c2" : "=&v"(lo[ks]) : "v"(vb), "i"(d0 * 4096 + ks * 1024) : "memory");
            asm volatile("ds_read_b64_tr_b16 %0,%1 offset:%c2" : "=&v"(hi[ks]) : "v"(vb), "i"(d0 * 4096 + ks * 1024 + 512) : "memory"); }
        asm volatile("s_waitcnt lgkmcnt(0)" ::: "memory"); SBAR();
#define PK(k) (bf16x8){lo[k][0], lo[k][1], lo[k][2], lo[k][3], hi[k][0], hi[k][1], hi[k][2], hi[k][3]}
        o[d0] = __builtin_amdgcn_mfma_f32_32x32x16_bf16(pa0, PK(0), o[d0], 0, 0, 0);
        o[d0] = __builtin_amdgcn_mfma_f32_32x32x16_bf16(pa1, PK(1), o[d0], 0, 0, 0);
        o[d0] = __builtin_amdgcn_mfma_f32_32x32x16_bf16(pa2, PK(2), o[d0], 0, 0, 0);
        o[d0] = __builtin_amdgcn_mfma_f32_32x32x16_bf16(pa3, PK(3), o[d0], 0, 0, 0);
#undef PK
    }
}
struct ConvItem { v4u cu[6], bg[4]; f32x4 wa[3], wb[3]; };
__device__ __forceinline__ void conv_issue(ConvItem& c, const bf16* CU, const bf16* ZB, const float* cw, long it) {
    const long row0 = (it >> 6) * 4; const int c8 = (int)(it & 63) * 8; const int sp0 = (int)(row0 & (SEQ - 1));
#pragma unroll
    for (int k = 0; k < 6; ++k) c.cu[k] = (sp0 - 2 + k >= 0) ? *(const v4u*)(CU + (row0 - 2 + k) * DCONV + c8) : (v4u){0u, 0u, 0u, 0u};
#pragma unroll
    for (int r = 0; r < 4; ++r) c.bg[r] = *(const v4u*)(ZB + (row0 + r) * 1024 + c8);
#pragma unroll
    for (int k = 0; k < 3; ++k) { c.wa[k] = *(const f32x4*)(cw + k * DCONV + c8); c.wb[k] = *(const f32x4*)(cw + k * DCONV + c8 + 4); }
}
__device__ __forceinline__ void conv_finish(const ConvItem& c, bf16* ZB, long it) {
    const long row0 = (it >> 6) * 4; const int c8 = (int)(it & 63) * 8;
    f32x4 ca[6], cb[6];
#pragma unroll
    for (int k = 0; k < 6; ++k) unpack8(c.cu[k], ca[k], cb[k]);
#pragma unroll
    for (int r = 0; r < 4; ++r) { const f32x4 accA = ca[r] * c.wa[0] + ca[r + 1] * c.wa[1] + ca[r + 2] * c.wa[2], accB = cb[r] * c.wb[0] + cb[r + 1] * c.wb[1] + cb[r + 2] * c.wb[2];
        f32x4 ba, bb; unpack8(c.bg[r], ba, bb); pg8::st16(ZB, (size_t)((row0 + r) * 1024 + c8), pack8(ba * accA, bb * accB)); }
}
template <int THRL> __device__ __forceinline__ void attn_unit(int wave, int b, int h, int qb, const bf16* Q, const bf16* __restrict__ K, const bf16* __restrict__ V, bf16* O, char* shm, const bf16* CU, const float* cw, long itb) {
    const int lane = fresh_lane(); int wid_ = wave; asm volatile("" : "+s"(wid_));
    const int r32 = lane & 31, hi = lane >> 5, wid = wid_;
    const long rowbase = (long)b * SEQ; const int q0 = qb * QBR;
    const bf16* Qw = Q + (rowbase + q0 + wid * 32) * QP + h * DQK;
    const bf16* Kh = K + rowbase * KP + h * DQK; const bf16* Vh = V + rowbase * VP + h * DVH;
    const unsigned lds0 = (unsigned)(uintptr_t)shm;
    float* wsf = (float*)(shm + LDS_WS) + wid * 64;
    const unsigned koff0 = (unsigned)(lane * KP + wid * 8) * 2u, koff1 = (unsigned)(lane * KP + (8 + (wid & 3)) * 8) * 2u;
    const unsigned voffv = (unsigned)((16 * (wid & 3) + (lane >> 2)) * VP + (wid >> 2) * 32 + (lane & 3) * 8) * 2u;
    const unsigned kdst0 = lds0 + LDS_K + wid * 1024, kdst1 = lds0 + LDS_K + (8 + (wid & 3)) * 1024, vdst = lds0 + LDS_V + wid * 1024;
#define DMA_K(t, slot) do { const bf16* kb_ = Kh + (long)(t) * KVBLK * KP; glds16s(koff0, kb_, (unsigned)__builtin_amdgcn_readfirstlane(kdst0 + (slot))); glds16s(koff1, kb_, (unsigned)__builtin_amdgcn_readfirstlane(kdst1 + (slot))); } while (0)
#define DMA_V(t, slot) glds16s(voffv, Vh + (long)(t) * KVBLK * VP, (unsigned)__builtin_amdgcn_readfirstlane(vdst + (slot)))
    const int vb0 = (int)(lds0 + LDS_V) + ((lane >> 4) & 1) * 32 + (lane & 3) * 8 + (4 * hi + ((lane & 15) >> 2)) * 64;
    const lds_cptr shm3 = (lds_cptr)shm; const lds_cptr kp0 = shm3 + LDS_K + hi * 1024 + r32 * 16; const lds_cptr vp0 = shm3 + LDS_V + ((lane >> 4) & 1) * 32 + (lane & 3) * 8 + (4 * hi + ((lane & 15) >> 2)) * 64;
    bf16x8 kf[8];
    const int NT = (q0 + QBR) / KVBLK;
    DMA_K(0, 0); DMA_V(0, 0); DMA_K(1, KSLOT);
    bf16x8 qr[6];
#pragma unroll
    for (int d0 = 0; d0 < 6; ++d0) qr[d0] = *reinterpret_cast<const bf16x8*>(&Qw[(long)r32 * QP + d0 * 16 + hi * 8]);
    float mhat = 0.f, l_reg = 0.f; f32x16 o[2]; o[0] = f32x16{}; o[1] = f32x16{}; f32x16 negm; { float z_ = 0.f; asm volatile("" : "+v"(z_)); _Pragma("unroll") for (int r = 0; r < 16; ++r) negm[r] = z_; }
    const int qrel = wid * 32 + r32;
#define CMASK(P0, P1, t) do { int jb_ = (t) - (NT - 4); if (jb_ >= 0) cmask(P0, P1, jb_, qrel, hi); } while (0)
    bool resc = false;
#define START(P0, P1) do { const float rm = rowmax(P0, P1); resc = false; \
    { const float dl = rm; mhat = fadd_s(mhat, dl); \
      _Pragma("unroll") for (int r = 0; r < 16; ++r) { P0[r] = fsub_s(P0[r], dl); P1[r] = fsub_s(P1[r], dl); } \
      _Pragma("unroll") for (int r = 0; r < 16; ++r) negm[r] = -mhat; asm volatile("" : "+v"(negm)); } \
    _Pragma("unroll") for (int r = 0; r < 16; ++r) P0[r] = __builtin_amdgcn_exp2f(P0[r]); } while (0)
#define RESC() do { if (resc) { asm volatile("s_waitcnt lgkmcnt(0)" ::: "memory"); \
      _Pragma("unroll") for (int d_ = 0; d_ < 2; ++d_) _Pragma("unroll") for (int r = 0; r < 16; ++r) o[d_][r] *= wsf[crow(r, hi)]; } } while (0)
    f32x16 pA0, pA1, pB0, pB1;
    int kprev = 3 * KSLOT, kcur = 0, knext = KSLOT;
    int vprev = 0, vcur = 0, vnext = VSLOT;
#define ROT() do { kprev = kcur; kcur = knext; knext = (knext == (NKS - 1) * KSLOT) ? 0 : knext + KSLOT; vprev = vcur; vcur = vnext; vnext = (vnext == (NVS - 1) * VSLOT) ? 0 : vnext + VSLOT; } while (0)
    DMA_K(2, 2 * KSLOT);
    WAIT_BAR(5);
    qkt(pA0, pA1, shm3 + LDS_K, qr, negm, r32, hi); asm volatile("s_nop 15\n\ts_nop 7" : "+v"(pA0), "+v"(pA1)); CMASK(pA0, pA1, 0);
    START(pA0, pA1);
    _Pragma("unroll") for (int r = 0; r < 16; ++r) pA1[r] = __builtin_amdgcn_exp2f(pA1[r]);
    WAIT_BAR(0);
    DMA_K(3, 3 * KSLOT); DMA_V(1, VSLOT);
    ROT();
#pragma unroll
    for (int j = 0; j < 4; ++j) kload2(kf, kp0 + kcur, j);
    WAIT_BAR(3);
    s16x4 vlo[8], vhi[8]; v4u pw0, pw1, pw2, pw3; bf16x8 kx0, kx1, kx2, kx3;
#define PKW(P, B) cvt_pk_bf16(P[B], P[B + 1])
#define PAF(k) __builtin_bit_cast(bf16x8, pw##k)
#define VFR(i) (bf16x8){vlo[i][0], vlo[i][1], vlo[i][2], vlo[i][3], vhi[i][0], vhi[i][1], vhi[i][2], vhi[i][3]}
#define PIN(x) asm volatile("" : "+v"(x))
#define MX3(a, b, c) __builtin_fmaxf(__builtin_fmaxf((a), (b)), (c))
#define MFQ(c, k, q, cin) c = __builtin_amdgcn_mfma_f32_32x32x16_bf16(kf[k], qr[q], cin, 0, 0, 0)
#define MFX(c, kx, q, cin) c = __builtin_amdgcn_mfma_f32_32x32x16_bf16(kx, qr[q], cin, 0, 0, 0)
#define GAPA(MF, A0, A1, A2, A3, W0, W1, PW) do { MF; sacc += A0; sacc += A1; sacc += A2; sacc += A3; PIN(sacc); W0; W1; PIN(PW); SBAR(); } while (0)
#define GAPN(MF) do { MF; SBAR(); } while (0)
#define EX(v) __builtin_amdgcn_exp2f(v)
#define GAPB(MF, X, B) do { MF; X[B] = EX(X[B]); X[B + 1] = EX(X[B + 1]); X[B + 2] = EX(X[B + 2]); X[B + 3] = EX(X[B + 3]); PIN(X); SBAR(); } while (0)
#define VRD(i) do { vlo[i] = vtr(vp_ + (((i) >> 2) * 4096 + ((i) & 3) * 1024)); vhi[i] = vtr(vp_ + (((i) >> 2) * 4096 + ((i) & 3) * 1024 + 512)); } while (0)
#define KRD(G, j) do { if (G) { kload2(kf, kp0 + knext, j); SBAR(); } } while (0)
#define STEP(C0, C1, P0, P1, t, GK, GV, GL) do { SBAR(); \
    const lds_cptr vp_ = vp0 + vprev; \
    VRD(0); SBAR(); float sacc = (P0[0] + P0[1]); \
    GAPA(MFQ(C0, 0, 0, negm), P0[2], P0[3], P0[4], P0[5],     pw0[0] = PKW(P0, 0), pw0[1] = PKW(P0, 2), pw0); \
    VRD(4); SBAR(); GAPA(MFQ(C1, 1, 0, negm), P0[6], P0[7], P0[8], P0[9],     pw0[2] = PKW(P0, 4), pw0[3] = PKW(P0, 6), pw0); \
    VRD(1); SBAR(); GAPA(MFQ(C0, 2, 1, C0),   P0[10], P0[11], P0[12], P0[13], pw1[0] = PKW(P0, 8), pw1[1] = PKW(P0, 10), pw1); \
    VRD(5); SBAR(); GAPA(MFQ(C1, 3, 1, C1),   P0[14], P0[15], P1[0], P1[1],   pw1[2] = PKW(P0, 12), pw1[3] = PKW(P0, 14), pw1); \
    VRD(2); SBAR(); GAPA(MFQ(C0, 4, 2, C0),   P1[2], P1[3], P1[4], P1[5],     pw2[0] = PKW(P1, 0), pw2[1] = PKW(P1, 2), pw2); \
    VRD(6); SBAR(); GAPA(MFQ(C1, 5, 2, C1),   P1[6], P1[7], P1[8], P1[9],     pw2[2] = PKW(P1, 4), pw2[3] = PKW(P1, 6), pw2); \
    VRD(3); kx0 = *(const LAS bf16x8*)(kp0 + kcur + 8192); kx1 = *(const LAS bf16x8*)(kp0 + kcur + 8192 + 512); SBAR(); GAPA(MFQ(C0, 6, 3, C0),   P1[10], P1[11], P1[12], P1[13], pw3[0] = PKW(P1, 8), pw3[1] = PKW(P1, 10), pw3); \
    VRD(7); kx2 = *(const LAS bf16x8*)(kp0 + kcur + 10240); kx3 = *(const LAS bf16x8*)(kp0 + kcur + 10240 + 512); SBAR(); GAPA(MFQ(C1, 7, 3, C1),   P1[14], P1[15], 0.f, 0.f,       pw3[2] = PKW(P1, 12), pw3[3] = PKW(P1, 14), pw3); \
    GAPN(MFX(C0, kx0, 4, C0)); GAPN(MFX(C1, kx1, 4, C1)); GAPN(MFX(C0, kx2, 5, C0)); GAPN(MFX(C1, kx3, 5, C1)); \
    l_reg += sacc; \
    if (GK) { DMA_K((t) + 3, kprev); } if (GV) { DMA_V((t) + 1, vnext); } \
    CMASK(C0, C1, t); \
    { float a = MX3(C0[0], C0[1], C1[0]), b = MX3(C0[2], C0[3], C1[1]); a = MX3(a, C1[2], C1[3]); \
      _Pragma("unroll") for (int r = 4; r < 16; r += 4) { a = MX3(a, C0[r], C0[r + 1]); b = MX3(b, C0[r + 2], C0[r + 3]); a = MX3(a, C1[r], C1[r + 1]); b = MX3(b, C1[r + 2], C1[r + 3]); } \
      float rm = __builtin_fmaxf(a, b); { auto rr = __builtin_amdgcn_permlane32_swap(__float_as_uint(rm), __float_as_uint(rm), false, false); rm = __builtin_fmaxf(__uint_as_float(rr[0]), __uint_as_float(rr[1])); } \
      resc = false; \
      if (__builtin_expect(__any(rm > (float)THRL), 0)) { const float dl = __builtin_fmaxf(rm, 0.f); mhat += dl; \
        _Pragma("unroll") for (int r = 0; r < 16; ++r) { C0[r] -= dl; C1[r] -= dl; } \
        _Pragma("unroll") for (int r = 0; r < 16; ++r) negm[r] = -mhat; asm volatile("" : "+v"(negm)); \
        const float f = __builtin_amdgcn_exp2f(-dl); l_reg *= f; if (hi == 0) wsf[r32] = f; resc = true; } } \
    SBAR(); \
    GAPB(o[0] = __builtin_amdgcn_mfma_f32_32x32x16_bf16(PAF(0), VFR(0), o[0], 0, 0, 0), C0, 0); \
    GAPB(o[1] = __builtin_amdgcn_mfma_f32_32x32x16_bf16(PAF(0), VFR(4), o[1], 0, 0, 0), C0, 4); \
    KRD(GL, 0); GAPB(o[0] = __builtin_amdgcn_mfma_f32_32x32x16_bf16(PAF(1), VFR(1), o[0], 0, 0, 0), C0, 8); \
    KRD(GL, 1); GAPB(o[1] = __builtin_amdgcn_mfma_f32_32x32x16_bf16(PAF(1), VFR(5), o[1], 0, 0, 0), C0, 12); \
    KRD(GL, 2); GAPB(o[0] = __builtin_amdgcn_mfma_f32_32x32x16_bf16(PAF(2), VFR(2), o[0], 0, 0, 0), C1, 0); \
    KRD(GL, 3); GAPB(o[1] = __builtin_amdgcn_mfma_f32_32x32x16_bf16(PAF(2), VFR(6), o[1], 0, 0, 0), C1, 4); \
    GAPB(o[0] = __builtin_amdgcn_mfma_f32_32x32x16_bf16(PAF(3), VFR(3), o[0], 0, 0, 0), C1, 8); \
    GAPB(o[1] = __builtin_amdgcn_mfma_f32_32x32x16_bf16(PAF(3), VFR(7), o[1], 0, 0, 0), C1, 12); \
    } while (0)
    int t = 1;
#undef CMASK
#define CMASK(P0, P1, t) do { } while (0)
    for (; t + 5 < NT; t += 2) {
        STEP(pB0, pB1, pA0, pA1, t, true, true, true);     WAIT_BAR(3); RESC(); ROT();
        STEP(pA0, pA1, pB0, pB1, t + 1, true, true, true); WAIT_BAR(3); RESC(); ROT();
    }
#undef CMASK
#define CMASK(P0, P1, t) do { int jb_ = (t) - (NT - 4); if (jb_ >= 0) cmask(P0, P1, jb_, qrel, hi); } while (0)
#define ENDW(tt) do { if ((tt) + 3 < NT) { WAIT_BAR(3); } else if ((tt) + 2 < NT) { WAIT_BAR(1); } else { WAIT_BAR(0); } } while (0)
    for (; t + 1 < NT; t += 2) {
        STEP(pB0, pB1, pA0, pA1, t, (t + 3 < NT), (t + 1 < NT), (t + 1 < NT));         ENDW(t);     RESC(); ROT();
        STEP(pA0, pA1, pB0, pB1, t + 1, (t + 4 < NT), (t + 2 < NT), (t + 2 < NT));     ENDW(t + 1); RESC(); ROT();
    }
    STEP(pB0, pB1, pA0, pA1, NT - 1, false, false, false); RESC();
    { float sacc = pB0[0] + pB0[1]; _Pragma("unroll") for (int r = 2; r < 16; ++r) sacc += pB0[r]; _Pragma("unroll") for (int r = 0; r < 16; ++r) sacc += pB1[r]; l_reg += sacc;
      pw0 = (v4u){PKW(pB0, 0), PKW(pB0, 2), PKW(pB0, 4), PKW(pB0, 6)}; pw1 = (v4u){PKW(pB0, 8), PKW(pB0, 10), PKW(pB0, 12), PKW(pB0, 14)}; pw2 = (v4u){PKW(pB1, 0), PKW(pB1, 2), PKW(pB1, 4), PKW(pB1, 6)}; pw3 = (v4u){PKW(pB1, 8), PKW(pB1, 10), PKW(pB1, 12), PKW(pB1, 14)};
      SBAR(); pv(o, vb0 + vcur, PAF(0), PAF(1), PAF(2), PAF(3)); }
#undef PKW
#undef PAF
#undef VFR
#undef PIN
#undef MX3
#undef MFQ
#undef MFX
#undef GAPA
#undef GAPN
#undef GAPB
#undef EX
#undef VRD
#undef KRD
#undef STEP
#undef ENDW
    ConvItem cv; const long cit = itb + wid * 64 + fresh_lane(); conv_issue(cv, CU, O, cw, cit);
    { auto rr = __builtin_amdgcn_permlane32_swap(__float_as_uint(l_reg), __float_as_uint(l_reg), false, false); l_reg = __uint_as_float(rr[0]) + __uint_as_float(rr[1]); }
    if (hi == 0) wsf[32 + r32] = l_reg; asm volatile("s_waitcnt lgkmcnt(0)" ::: "memory");
    float rli[16];
#pragma unroll
    for (int r = 0; r < 16; ++r) rli[r] = __builtin_amdgcn_rcpf(wsf[32 + crow(r, hi)]);
    bf16* Ow = O + (rowbase + q0 + wid * 32) * OP + 512 + h * DVH;
    { bf16* stg = (bf16*)(shm + LDS_OST) + wid * 2048;
#pragma unroll
      for (int r = 0; r < 16; ++r) { const int orow = crow(r, hi);
#pragma unroll
        for (int d0 = 0; d0 < 2; ++d0) stg[orow * 64 + d0 * 32 + r32] = (bf16)(cvt_pk_bf16(o[d0][r] * rli[r], 0.f) & 0xffffu); }
      asm volatile("s_waitcnt lgkmcnt(0)" ::: "memory");
#pragma unroll
      for (int i = 0; i < 4; ++i) { const int row = i * 8 + (lane >> 3), ch = lane & 7; const v4u v = *(const v4u*)(stg + row * 64 + ch * 8); pg8::st16(Ow, (size_t)(row * OP + ch * 8), v); } }
    conv_finish(cv, O, cit);
    asm volatile("s_waitcnt lgkmcnt(0)\n\ts_barrier" ::: "memory");
#undef DMA_K
#undef DMA_V
#undef CMASK
#undef START
#undef RESC
#undef ROT
}
#undef SBAR
#undef WAIT_BAR
}

constexpr int NWAVES = 8, GRID = 256;
constexpr int RING_OFF = 0, RING_BYTES = 131072;
constexpr int LDSCTL_OFF = RING_BYTES, MISC_OFF = LDSCTL_OFF + 320, RS_OFF = RING_BYTES + 1024;
constexpr int MOETAB_OFF = RS_OFF + 2048;
constexpr int LDS_BYTES = 147456;
static_assert(att::L2_BYTES <= RING_BYTES && att2::LDS_BYTES <= RING_BYTES && RS_OFF + 2048 <= LDS_BYTES, "lds map");

#define RLX_AGENT __ATOMIC_RELAXED, __HIP_MEMORY_SCOPE_AGENT
#define LDS_WAIT() asm volatile("s_waitcnt lgkmcnt(0)" ::: "memory")
#define VM_WAIT() asm volatile("s_waitcnt vmcnt(0)" ::: "memory")

#define XB_TMO      128
#define XB_XCNT(j)  (256  + 64 * (j))
#define XB_XSUB(j)  (1280 + 64 * (j))
#define XB_XGEN(j)  (2304 + 64 * (j))
#define XB_TOP      3328
#define XB_TOPGEN   3392
#define XCD_BAR_WORDS 3456
#define XB_SPIN_CAP (1u << 18)
__device__ __forceinline__ unsigned xb_ld(unsigned* p)              { return __hip_atomic_load(p, __ATOMIC_RELAXED, __HIP_MEMORY_SCOPE_AGENT); }
__device__ __forceinline__ unsigned xb_add(unsigned* p, unsigned v) { return __hip_atomic_fetch_add(p, v, __ATOMIC_RELAXED, __HIP_MEMORY_SCOPE_AGENT); }
__device__ __forceinline__ unsigned xb_xcc_id() { return (unsigned)__builtin_amdgcn_s_getreg((3 << 11) | 20) & 0xFu; }
#define XB_SPIN(cond, bar) do { unsigned _sp = 0; while (cond) { __builtin_amdgcn_s_sleep(1); \
    if ((++_sp & 255u) == 0u) { if (xb_ld(&(bar)[XB_TMO])) break; if (_sp > XB_SPIN_CAP) { atomicAdd(&(bar)[XB_TMO], 1u); break; } } } } while (0)
struct XcdBarrier { unsigned* bar; unsigned x; volatile LAS unsigned* st; };
__device__ __forceinline__ XcdBarrier xcd_barrier_post(unsigned* bar, volatile LAS unsigned* st) {
    XcdBarrier b; b.bar = bar; b.x = (unsigned)__builtin_amdgcn_readfirstlane((int)xb_xcc_id()); b.st = st;
    if (threadIdx.x == 0) (void)xb_add(&bar[XB_XCNT(b.x)], 1u);
    return b;
}
__device__ __forceinline__ void xcd_barrier_complete(unsigned* bar, unsigned x, unsigned& nloc, unsigned& nx) {
    const unsigned G = (unsigned)GRID;
    unsigned sum, cnt, mine, sp = 0u;
    for (;;) {
        sum = 0u; cnt = 0u; mine = 0u;
#pragma unroll
        for (unsigned j = 0; j < 16; ++j) { const unsigned c = xb_ld(&bar[XB_XCNT(j)]); sum += c; cnt += (c > 0u) ? 1u : 0u; mine = (j == x) ? c : mine; }
        if (sum == G) break;
        __builtin_amdgcn_s_sleep(1);
        if ((++sp & 255u) == 0u) { if (xb_ld(&bar[XB_TMO])) break; if (sp > XB_SPIN_CAP) { atomicAdd(&bar[XB_TMO], 1u); break; } }
    }
    nloc = mine > 0u ? mine : 1u; nx = cnt > 0u ? cnt : 1u;
}
template <bool REL = true> __device__ __forceinline__ void xcd_barrier(const XcdBarrier& b) {
    asm volatile("s_waitcnt vmcnt(0)" ::: "memory");
    __syncthreads();
    if (threadIdx.x == 0) {
        unsigned* bar = b.bar;
        __builtin_amdgcn_s_waitcnt(0);
        unsigned nloc = b.st[0], nx = b.st[1];
        if (nloc == 0u) { xcd_barrier_complete(bar, b.x, nloc, nx); b.st[0] = nloc; b.st[1] = nx; }
        const unsigned old = xb_add(&bar[XB_XSUB(b.x)], 1u);
        const unsigned gen = old / nloc;
        if (old + 1u == (gen + 1u) * nloc) {
            if constexpr (REL) { __builtin_amdgcn_fence(__ATOMIC_RELEASE, "agent");
            asm volatile("s_waitcnt vmcnt(0)" ::: "memory"); }
            const unsigned og = xb_add(&bar[XB_TOP], 1u);
            const unsigned tg = og / nx;
            if (og + 1u == (tg + 1u) * nx) xb_add(&bar[XB_TOPGEN], 1u);
            else XB_SPIN(xb_ld(&bar[XB_TOPGEN]) == tg, bar);
            xb_add(&bar[XB_XGEN(b.x)], 1u);
            __builtin_amdgcn_fence(__ATOMIC_ACQUIRE, "agent");
            asm volatile("s_waitcnt vmcnt(0)" ::: "memory");
        } else {
            XB_SPIN(xb_ld(&bar[XB_XGEN(b.x)]) == gen, bar);
            __builtin_amdgcn_fence(__ATOMIC_ACQUIRE, "agent");
            asm volatile("s_waitcnt vmcnt(0)" ::: "memory");
        }
    }
    __syncthreads();
}

struct Args {
    const float *x; const int* pos; const float *attn_norm, *w_in, *conv_w, *w_conv_out, *q_norm, *w_uq, *kv_norm, *w_ukv, *w_mla_out, *w_o, *ffn_norm,
                *w_gate, *w_up, *w_down, *router, *w_gate_e, *w_up_e, *w_down_e, *final_norm;
    float* out; unsigned char* ws;
};
struct Frame { LAS unsigned char* lds; int tid, lane, wave, vcu; };
#define FRESH_LANE(F) do { const int l_ = fresh_lane(); (F).lane = l_; (F).tid = (F).wave * 64 + l_; } while (0)
typedef const __attribute__((address_space(4))) struct Args* kargs_t;
#define FRESH_ARGS() ({ kargs_t p_ = (kargs_t)__builtin_amdgcn_kernarg_segment_ptr(); asm volatile("" : "+s"(p_)); p_; })

__device__ __forceinline__ float wave_sum(float v) {
    v += swz_xor<1>(v); v += swz_xor<2>(v); v += swz_xor<4>(v); v += swz_xor<8>(v); v += swz_xor<16>(v);
    return xadd32(v);
}
__device__ __forceinline__ unsigned f2bf(float f) { unsigned u = __builtin_bit_cast(unsigned, f); return (u + 0x7fffu + ((u >> 16) & 1u)) >> 16; }
__device__ __forceinline__ unsigned pk2(float lo, float hi) { return f2bf(lo) | (f2bf(hi) << 16); }

enum { MAP_NAT = 0, MAP_WIN = 1, MAP_WUQ = 2, MAP_GU = 3 };
__device__ __forceinline__ int rope_pos_to_idx(int p) { return 16 * ((p & 7) >> 2) + 4 * (p >> 3) + (p & 3); }
__device__ __forceinline__ int map_src(int map, int d, int& which) {
    which = 0;
    if (map == MAP_NAT) return d;
    if (map == MAP_WUQ) { const int h = d / 96, w = d % 96; return w < 64 ? d : h * 96 + 64 + rope_pos_to_idx(w - 64); }
    if (map == MAP_GU) { const int t = d >> 8, r = d & 255; which = r >> 7; return t * 128 + (r & 127); }
    const int pn = d >> 8, r = d & 255;
    if (pn < 4) return (r < 128 ? 512 : 1024) + pn * 128 + (r & 127);
    if (pn < 6) return d - 1024;
    if (pn == 6) return 1536 + r;
    if (pn == 7) { if (r < 128) return 1792 + r; if (r < 160) return 2176 + rope_pos_to_idx(r - 128); return -1; }
    if (pn == 8) return 1920 + r;
    const int t = pn - 9; return (r < 128 ? 2208 : 3232) + t * 128 + (r & 127);
}
__device__ __forceinline__ void conv_item(const float* W, int ldk, int Nsrc, bf16* WT, int d0, int k0, int sc, const float* gain, LAS float* scr, int lane) {
    float v[32];
#pragma unroll
    for (int i = 0; i < 32; ++i) { const int kk = 2 * i + (lane >> 5); v[i] = sc >= 0 ? W[(size_t)(k0 + kk) * Nsrc + sc] : 0.f; }
    if (gain) {
#pragma unroll
        for (int i = 0; i < 32; ++i) v[i] *= gain[k0 + 2 * i + (lane >> 5)]; }
#pragma unroll
    for (int i = 0; i < 32; ++i) scr[(2 * i + (lane >> 5)) * 33 + (lane & 31)] = v[i];
    LDS_WAIT(); asm volatile("" ::: "memory");
    const int c = lane & 7;
#pragma unroll
    for (int j = 0; j < 4; ++j) { const int n = (lane >> 3) + 8 * j; const LAS float* s = scr + (8 * c) * 33 + n;
        v4u o; o.x = pk2(s[0 * 33], s[1 * 33]); o.y = pk2(s[2 * 33], s[3 * 33]); o.z = pk2(s[4 * 33], s[5 * 33]); o.w = pk2(s[6 * 33], s[7 * 33]);
        pg8::st16(WT, (size_t)(d0 + n) * ldk + k0 + 8 * c, o); }
    LDS_WAIT(); asm volatile("" ::: "memory");
}
__device__ __forceinline__ long conv_matrix(Frame& F, long base, const float* W, const float* W2, int K, int Nsrc, int Ndest, bf16* WT, const float* gain, int map, int ldk = 0, int wg = -1, int nwg = GRID) {
    LAS float* scr = (LAS float*)(F.lds + RING_OFF + F.wave * 16384);
    const long gw = (long)(wg < 0 ? F.vcu : wg) * NWAVES + F.wave, NGW = (long)nwg * NWAVES;
    const int nb = Ndest / 32; const long n = (long)(K / 64) * nb; if (ldk == 0) ldk = K;
    long g = gw + ((base - gw + NGW - 1) / NGW) * NGW; if (g < base) g += NGW;
    for (; g < base + n; g += NGW) { const int it = (int)(g - base), kb = it / nb, db = it % nb; int which; const int sc = map_src(map, db * 32 + (F.lane & 31), which);
        const int w0 = __builtin_amdgcn_readfirstlane(which);
        conv_item(w0 ? W2 : W, ldk, Nsrc, WT, db * 32, kb * 64, sc, gain, scr, F.lane); }
    return base + n;
}


#ifndef LATE_CONV
#define LATE_CONV 2
#endif
#ifndef STOP_AFTER
#define STOP_AFTER 0
#endif
__device__ __forceinline__ void dump_fold(float* out, const bf16* b0, int ld0, int w0, const bf16* b1, int ld1, int w1, const bf16* b2, int ld2, int w2, const bf16* b3, int ld3, int w3, int bid, int tid) {
    for (long i = (long)bid * 512 + tid; i < (long)M * 1024; i += (long)GRID * 512) { const long r = i >> 10; const int c = (int)(i & 1023); float v = 0.f;
        if (b0) v += bflo(b0[r * ld0 + (c % w0)]); if (b1) v += 2.f * bflo(b1[r * ld1 + (c % w1)]); if (b2) v += 3.f * bflo(b2[r * ld2 + (c % w2)]); if (b3) v += 5.f * bflo(b3[r * ld3 + (c % w3)]);
        out[i] = v; }
}
__global__ void __launch_bounds__(NWAVES * 64, 2) trunk_fwd(Args a_unused) {
    extern __shared__ __attribute__((aligned(16))) unsigned char lds[];
    Frame F;
    F.lds = (LAS unsigned char*)lds;
    volatile LAS unsigned* MISC = (volatile LAS unsigned*)(F.lds + MISC_OFF);
    F.tid = threadIdx.x; F.lane = F.tid & 63; { int w_ = __builtin_amdgcn_readfirstlane(F.tid >> 6); asm volatile("" : "+s"(w_)); F.wave = w_; }
    { const int bx = blockIdx.x; F.vcu = (bx % 8) * (GRID / 8) + bx / 8; }
    for (int u = F.tid; u < (LDS_BYTES - LDSCTL_OFF) / 4; u += NWAVES * 64) ((LAS unsigned*)(F.lds + LDSCTL_OFF))[u] = 0u;
    __syncthreads();
    XcdBarrier bar = xcd_barrier_post((unsigned*)(FRESH_ARGS()->ws + WS_CTL) + CW_BAR, MISC + 8);
#define GRID_BAR() do { GRID_BAR1(); if (DUPB > 1) GRID_BAR1(); } while (0)
#define GRID_BAR1() do { XcdBarrier b2_; b2_.x = bar.x; asm volatile("" : "+s"(b2_.x)); b2_.st = MISC + 8; b2_.bar = (unsigned*)(FRESH_ARGS()->ws + WS_CTL) + CW_BAR; xcd_barrier<true>(b2_); } while (0)
#ifdef NO_LIGHT_BAR
#define GRID_BAR_WT() GRID_BAR()
#else
#define GRID_BAR_WT() do { XcdBarrier b2_; b2_.x = bar.x; asm volatile("" : "+s"(b2_.x)); b2_.st = MISC + 8; b2_.bar = (unsigned*)(FRESH_ARGS()->ws + WS_CTL) + CW_BAR; xcd_barrier<false>(b2_); } while (0)
#endif
#define WSP(T, off) ((T*)(ws + (off)))
#define MOE_TABLE() do { if (F.tid == 0) { LAS int* tab_ = (LAS int*)(F.lds + MOETAB_OFF); const unsigned* cnt_ = (const unsigned*)(ws + WS_CTL) + CW_CNT; int t_ = 0; \
        for (int e_ = 0; e_ < NE; ++e_) { const int n_ = (int)__hip_atomic_load(cnt_ + e_, RLX_AGENT); tab_[e_] = t_; tab_[NE + 1 + e_] = n_; t_ += (n_ + 255) / 256; } tab_[NE] = t_; } \
        LDS_WAIT(); __syncthreads(); } while (0)
#ifdef NO_EARLY_DOWN
#define MOE_NEARLY() 0
#else
#define MOE_NEARLY() ({ int n_ = 4 * __builtin_amdgcn_readfirstlane(((const LAS int*)(F.lds + MOETAB_OFF))[NE]) - 2 * GRID; n_ < 0 ? 0 : (n_ > 32 ? 32 : n_); })
#endif
#define PHASE_BEGIN() FRESH_LANE(F); int bid = blockIdx.x; asm volatile("" : "+s"(bid)); (void)bid; kargs_t ka = FRESH_ARGS(); unsigned char* const ws = ka->ws; LAS float* const rsb = (LAS float*)(F.lds + RS_OFF); \
        const long gw = (long)F.vcu * NWAVES + F.wave, NGW = (long)GRID * NWAVES; (void)gw; (void)NGW; (void)rsb; (void)ws

#ifndef SKIP_P0
    for (int rep0_ = 0; rep0_ < DUP0; ++rep0_) {
        PHASE_BEGIN();
        bf16* WB = WSP(bf16, WS_W);
        long base = 0;
#pragma unroll 1
        for (int l = 0; l < (LATE_CONV ? 1 : 2); ++l) {
            base = conv_matrix(F, base, ka->w_in + (size_t)l * DM * DIN, nullptr, DM, DIN, DINP, WB + WO_IN + l * W_IN_EL, ka->attn_norm + l * DM, MAP_WIN);
            base = conv_matrix(F, base, ka->w_uq + (size_t)l * QLORA * 768, nullptr, QLORA, 768, 768, WB + WO_UQ + l * W_UQ_EL, ka->q_norm + l * QLORA, MAP_WUQ);
            base = conv_matrix(F, base, ka->w_ukv + (size_t)l * KVLORA * 1024, nullptr, KVLORA, 1024, 1024, WB + WO_UKV + l * W_UKV_EL, ka->kv_norm + l * KVLORA, MAP_NAT);
            base = conv_matrix(F, base, ka->w_conv_out + (size_t)l * DCONV * DM, nullptr, DCONV, DM, DM, WB + WO_C + l * 2 * W_CM_EL, nullptr, MAP_NAT, 1024);
            base = conv_matrix(F, base, ka->w_mla_out + (size_t)l * 512 * DM, nullptr, 512, DM, DM, WB + WO_C + l * 2 * W_CM_EL + 512, nullptr, MAP_NAT, 1024);
            base = conv_matrix(F, base, ka->w_o + (size_t)l * DM * DM, nullptr, DM, DM, DM, WB + WO_O + l * W_O_EL, nullptr, MAP_NAT);
        }
        if (LATE_CONV < 2) base = conv_matrix(F, base, ka->w_gate, ka->w_up, DM, DFF, 2 * DFF, WB + WO_GU, ka->ffn_norm, MAP_GU);
        if (!LATE_CONV) base = conv_matrix(F, base, ka->w_down, nullptr, DFF, DM, DM, WB + WO_D, nullptr, MAP_NAT);
        bf16* XB = WSP(bf16, WS_XB); float* PART = WSP(float, WS_PART); float* COS = WSP(float, WS_COS); float* SIN = WSP(float, WS_SIN);
        const float* x = ka->x; const int* pos = ka->pos;
        for (long mrow0 = gw; mrow0 < M; mrow0 += 4 * NGW) {
            f32x4 v[4][4];
#pragma unroll
            for (int r = 0; r < 4; ++r) { const GAS f32x4* xr = (const GAS f32x4*)(x + (size_t)(mrow0 + r * NGW) * DM) + F.lane;
#pragma unroll
                for (int j = 0; j < 4; ++j) v[r][j] = xr[64 * j]; }
#pragma unroll
            for (int r = 0; r < 4; ++r) { const long mrow = mrow0 + r * NGW; float s = 0.f;
#pragma unroll
                for (int j = 0; j < 4; ++j) s += (v[r][j][0] * v[r][j][0] + v[r][j][1] * v[r][j][1]) + (v[r][j][2] * v[r][j][2] + v[r][j][3] * v[r][j][3]);
                s = wave_sum(s);
                GAS unsigned long long* o8 = (GAS unsigned long long*)(XB + (size_t)mrow * DM) + F.lane;
#pragma unroll
                for (int j = 0; j < 4; ++j) o8[64 * j] = (unsigned long long)pk2(v[r][j][0], v[r][j][1]) | ((unsigned long long)pk2(v[r][j][2], v[r][j][3]) << 32);
                if (F.lane < 16) PART[mrow * 16 + F.lane] = F.lane == 0 ? s : 0.f; }
        }
        for (int i = bid * 512 + F.tid; i < M * 16; i += GRID * 512) {
            const int f = i & 15; const float inv = powf(10000.0f, -(float)(2 * f) / 32.0f); const float ang = (float)pos[i >> 4] * inv;
            COS[i] = cosf(ang); SIN[i] = sinf(ang); }
    }
#endif
    GRID_BAR();

#pragma unroll 1
    for (int l = 0; l < 2; ++l) {
#ifndef SKIP_P1
        {
            PHASE_BEGIN();
            pg8::Gemm g{WSP(bf16, WS_XB), WSP(bf16, WS_W) + WO_IN + l * W_IN_EL, DM, DM}; pg8::StaticOrder S; S.init(M, DINP - 256, GRID, bid);
            pg8::EpiIn E{ws};
            pg8::RsPart<16> R{WSP(float, WS_PART), 1.0f / DM};
            for (int rep_ = 0; rep_ < DUP1; ++rep_)
            pg8::gemm_phase<pg8::EpiIn, pg8::StaticOrder, pg8::RsPart<16>, false, true>(F.wave, F.lds + RING_OFF, rsb, g, S, E, R, nullptr, 0);
        }
#endif
        GRID_BAR();
        if (STOP_AFTER == 1) { PHASE_BEGIN(); dump_fold(ka->out, WSP(bf16, WS_CU), 512, 512, WSP(bf16, WS_S1), 1024, 1024, WSP(bf16, WS_S2), 1024, 1024, WSP(bf16, WS_ZATT), 1024, 512, bid, F.tid); return; }
        if (STOP_AFTER == 11) { PHASE_BEGIN(); dump_fold(ka->out, WSP(bf16, WS_CQ), 384, 384, WSP(bf16, WS_CKV), 256, 256, WSP(bf16, WS_K), 768, 768, nullptr, 0, 1, bid, F.tid); return; }
#ifndef SKIP_P2
        {
            for (int rep2_ = 0; rep2_ < DUP2; ++rep2_) {
            { PHASE_BEGIN();
              if (bid < 64) {
                pg8::Gemm g{WSP(bf16, WS_XB), WSP(bf16, WS_W) + WO_IN + l * W_IN_EL, DM, DM}; pg8::OneTileOrder S{bid, 16, true};
                pg8::EpiIn E{ws}; pg8::RsPart<16> R{WSP(float, WS_PART), 1.0f / DM};
                pg8::gemm_phase<pg8::EpiIn, pg8::OneTileOrder, pg8::RsPart<16>, false, false>(F.wave, F.lds + RING_OFF, rsb, g, S, E, R, nullptr, 0);
              } else {
                { pg8::Gemm g{WSP(bf16, WS_CKV), WSP(bf16, WS_W) + WO_UKV + l * W_UKV_EL, KVLORA, KVLORA}; pg8::StaticOrder S; S.init(M, 1024, GRID - 64, bid - 64);
                  pg8::EpiKV E{WSP(bf16, WS_K), WSP(bf16, WS_V), WSP(float, WS_SSQKV)}; pg8::RsNone R;
                  pg8::gemm_phase<pg8::EpiKV, pg8::StaticOrder, pg8::RsNone, false, true>(F.wave, F.lds + RING_OFF, rsb, g, S, E, R, nullptr, 0); }
                { pg8::Gemm g{WSP(bf16, WS_CQ), WSP(bf16, WS_W) + WO_UQ + l * W_UQ_EL, QLORA, QLORA}; pg8::StaticOrder S; S.init(M, 768, GRID - 64, (bid - 64 + 64) % (GRID - 64));
                  pg8::EpiQ E{WSP(bf16, WS_Q), WSP(float, WS_COS), WSP(float, WS_SIN), WSP(float, WS_SSQQ)}; pg8::RsNone R;
                  pg8::gemm_phase<pg8::EpiQ, pg8::StaticOrder, pg8::RsNone, false, true>(F.wave, F.lds + RING_OFF, rsb, g, S, E, R, nullptr, 0); }
              } }
            if (LATE_CONV >= 2 && l == 0) { PHASE_BEGIN();
                if (bid >= 128) { long base = 0;
                    base = conv_matrix(F, base, ka->w_gate, ka->w_up, DM, DFF, 2 * DFF, WSP(bf16, WS_W) + WO_GU, ka->ffn_norm, MAP_GU, 0, bid - 128, 128); (void)base; } }
            }
        }
#endif
        GRID_BAR_WT();
        if (STOP_AFTER == 2) { PHASE_BEGIN(); dump_fold(ka->out, WSP(bf16, WS_Q), 768, 768, WSP(bf16, WS_K), 768, 768, WSP(bf16, WS_V), 512, 512, WSP(bf16, WS_ZATT), 1024, 512, bid, F.tid); return; }
#ifndef SKIP_P3
        {
            PHASE_BEGIN();
            const int bh = F.vcu >> 2, s = F.vcu & 3;
            for (int rep3_ = 0; rep3_ < DUP3; ++rep3_)
#ifdef ATTN_V2
                att::attn_pair(F.wave, bh / NH, bh % NH, s, 7 - s, WSP(bf16, WS_Q), WSP(bf16, WS_K), WSP(bf16, WS_V), WSP(bf16, WS_ZATT), (char*)lds + RING_OFF);
#else
                { const float* cw = ka->conv_w + (size_t)l * 3 * DCONV;
                  att2::attn_unit<8>(F.wave, bh / NH, bh % NH, s, WSP(bf16, WS_Q), WSP(bf16, WS_K), WSP(bf16, WS_V), WSP(bf16, WS_ZATT), (char*)lds + RING_OFF, WSP(bf16, WS_CU), cw, (long)F.vcu * 512);
                  att2::attn_unit<8>(F.wave, bh / NH, bh % NH, 7 - s, WSP(bf16, WS_Q), WSP(bf16, WS_K), WSP(bf16, WS_V), WSP(bf16, WS_ZATT), (char*)lds + RING_OFF, WSP(bf16, WS_CU), cw, (long)(GRID + F.vcu) * 512); }
#endif
        }
#endif
        GRID_BAR_WT();
        if (STOP_AFTER == 3) { PHASE_BEGIN(); dump_fold(ka->out, WSP(bf16, WS_ZATT), 1024, 1024, nullptr, 0, 1, nullptr, 0, 1, nullptr, 0, 1, bid, F.tid); return; }
#ifndef SKIP_P4
        for (int rep4_ = 0; rep4_ < DUP4; ++rep4_) {
            PHASE_BEGIN();
            pg8::Gemm g{WSP(bf16, WS_ZATT), WSP(bf16, WS_W) + WO_C + l * 2 * W_CM_EL, 1024, 1024}; pg8::StaticOrder S; S.init(M, DM, GRID, bid);
            pg8::EpiMerge E{WSP(bf16, WS_S1), WSP(bf16, WS_S2), WSP(bf16, WS_MERGED)}; pg8::RsNone R;
            pg8::gemm_phase<pg8::EpiMerge, pg8::StaticOrder, pg8::RsNone, false, false>(F.wave, F.lds + RING_OFF, rsb, g, S, E, R, nullptr, 0);
        }
#endif
        GRID_BAR_WT();
        if (STOP_AFTER == 4) { PHASE_BEGIN(); dump_fold(ka->out, WSP(bf16, WS_MERGED), 1024, 1024, nullptr, 0, 1, nullptr, 0, 1, nullptr, 0, 1, bid, F.tid); return; }
#ifndef SKIP_P5
        {
            { PHASE_BEGIN();
              pg8::Gemm g{WSP(bf16, WS_MERGED), WSP(bf16, WS_W) + WO_O + l * W_O_EL, DM, DM}; pg8::StaticOrder S; S.init(M, DM, GRID, bid);
              pg8::RsNone R;
              if (l == 0) { pg8::EpiRes<false> E{WSP(bf16, WS_XB), WSP(bf16, WS_XB), WSP(float, WS_PART)};
                for (int rep5_ = 0; rep5_ < 1; ++rep5_)
                pg8::gemm_phase<pg8::EpiRes<false>, pg8::StaticOrder, pg8::RsNone, false, false>(F.wave, F.lds + RING_OFF, rsb, g, S, E, R, nullptr, 0); }
              else { pg8::EpiRes<true> E{WSP(bf16, WS_XB), WSP(bf16, WS_X1B), WSP(float, WS_PART)};
                pg8::gemm_phase<pg8::EpiRes<true>, pg8::StaticOrder, pg8::RsNone, false, false>(F.wave, F.lds + RING_OFF, rsb, g, S, E, R, nullptr, 0); } }
            if (l == 1) for (int repc_ = 0; repc_ < DUPC; ++repc_) {
                PHASE_BEGIN();
                long base = 0;
#pragma unroll 1
                for (int e = 0; e < NE; ++e) {
                    base = conv_matrix(F, base, ka->w_gate_e + (size_t)e * DM * DFFE, ka->w_up_e + (size_t)e * DM * DFFE, DM, DFFE, 2 * DFFE, WSP(bf16, WS_WGUE) + (size_t)e * 2 * DFFE * DM, ka->ffn_norm + DM, MAP_GU);
                    base = conv_matrix(F, base, ka->w_down_e + (size_t)e * DFFE * DM, nullptr, DFFE, DM, DM, WSP(bf16, WS_WDE) + (size_t)e * DM * DFFE, nullptr, MAP_NAT);
                }
            }
        }
#endif
        if (l == 0) GRID_BAR();
        if (STOP_AFTER == 5) return;
        if (l == 0) {
#ifndef SKIP_P6
            {
                PHASE_BEGIN();
                pg8::Gemm g{WSP(bf16, WS_XB), WSP(bf16, WS_W) + WO_GU, DM, DM}; pg8::StaticOrder S; S.init(M, 2 * DFF, GRID, bid);
                pg8::EpiUp E{WSP(bf16, WS_HD), DFF, nullptr}; pg8::RsPart<16> R{WSP(float, WS_PART), 1.0f / DM};
                for (int rep_ = 0; rep_ < DUP6; ++rep_)
                pg8::gemm_phase<pg8::EpiUp, pg8::StaticOrder, pg8::RsPart<16>, false, true>(F.wave, F.lds + RING_OFF, rsb, g, S, E, R, nullptr, 0);
                if (LATE_CONV && bid >= S.nwg - 5 * GRID) {
                    bf16* WB = WSP(bf16, WS_W); const int wg = bid - (S.nwg - 5 * GRID), nw = 6 * GRID - S.nwg; long base = 0;
                    base = conv_matrix(F, base, ka->w_down, nullptr, DFF, DM, DM, WB + WO_D, nullptr, MAP_NAT, 0, wg, nw);
                    base = conv_matrix(F, base, ka->w_in + (size_t)DM * DIN, nullptr, DM, DIN, DINP, WB + WO_IN + W_IN_EL, ka->attn_norm + DM, MAP_WIN, 0, wg, nw);
                    base = conv_matrix(F, base, ka->w_uq + (size_t)QLORA * 768, nullptr, QLORA, 768, 768, WB + WO_UQ + W_UQ_EL, ka->q_norm + QLORA, MAP_WUQ, 0, wg, nw);
                    base = conv_matrix(F, base, ka->w_ukv + (size_t)KVLORA * 1024, nullptr, KVLORA, 1024, 1024, WB + WO_UKV + W_UKV_EL, ka->kv_norm + KVLORA, MAP_NAT, 0, wg, nw);
                    base = conv_matrix(F, base, ka->w_conv_out + (size_t)DCONV * DM, nullptr, DCONV, DM, DM, WB + WO_C + 2 * W_CM_EL, nullptr, MAP_NAT, 1024, wg, nw);
                    base = conv_matrix(F, base, ka->w_mla_out + (size_t)512 * DM, nullptr, 512, DM, DM, WB + WO_C + 2 * W_CM_EL + 512, nullptr, MAP_NAT, 1024, wg, nw);
                    base = conv_matrix(F, base, ka->w_o + (size_t)DM * DM, nullptr, DM, DM, DM, WB + WO_O + W_O_EL, nullptr, MAP_NAT, 0, wg, nw);
                }
            }
#endif
            GRID_BAR_WT();
            if (STOP_AFTER == 6) { PHASE_BEGIN(); dump_fold(ka->out, WSP(bf16, WS_HD), 2816, 1024, WSP(bf16, WS_HD) + 1024, 2816, 1024, WSP(bf16, WS_HD) + 1792, 2816, 1024, nullptr, 0, 1, bid, F.tid); return; }
#ifndef SKIP_P7
            {
                PHASE_BEGIN();
                pg8::Gemm g{WSP(bf16, WS_HD), WSP(bf16, WS_W) + WO_D, DFF, DFF}; pg8::StaticOrder S; S.init(M, DM, GRID, bid);
                pg8::EpiRes<false> E{WSP(bf16, WS_XB), WSP(bf16, WS_XB), WSP(float, WS_PART)}; pg8::RsNone R;
                pg8::gemm_phase<pg8::EpiRes<false>, pg8::StaticOrder, pg8::RsNone, false, false>(F.wave, F.lds + RING_OFF, rsb, g, S, E, R, nullptr, 0);
            }
#endif
            GRID_BAR();
            if (STOP_AFTER == 7) return;
        } else {
#ifndef SKIP_PR
            {
                PHASE_BEGIN();
                if (F.tid == 0) { unsigned* bar_ = (unsigned*)(ws + WS_CTL) + CW_BAR; unsigned* rdy_ = (unsigned*)(ws + WS_CTL) + CW_RDY2; XB_SPIN(xb_ld(rdy_) < (unsigned)(GRID * NWAVES), bar_); }
                __syncthreads();
                __builtin_amdgcn_fence(__ATOMIC_ACQUIRE, "agent");
                LAS int* sE = (LAS int*)(F.lds + RING_OFF); LAS float* sW = (LAS float*)(F.lds + RING_OFF + 1024);
                unsigned* CNT = (unsigned*)(ws + WS_CTL) + CW_CNT;
                float* RSTD1 = WSP(float, WS_RSTD1); int* TOPE = WSP(int, WS_TOPE); float* TOPW = WSP(float, WS_TOPW); int* TOPP = WSP(int, WS_TOPP); int* LIST = WSP(int, WS_LIST);
                const bf16* xo = WSP(bf16, WS_X1B);
                float gr[16][8];
                { const float* fn = ka->ffn_norm + DM; const float* router = ka->router;
#pragma unroll
                for (int j = 0; j < 4; ++j)
#pragma unroll
                    for (int i = 0; i < 4; ++i) { const int k = 4 * F.lane + 256 * j + i; const float gk = fn[k]; const f32x4 r0 = *(const f32x4*)(router + k * 8), r1 = *(const f32x4*)(router + k * 8 + 4);
#pragma unroll
                        for (int e = 0; e < 4; ++e) { gr[j * 4 + i][e] = gk * r0[e]; gr[j * 4 + i][4 + e] = gk * r1[e]; } } }
                for (int grp = F.vcu; grp < M / 64; grp += GRID) {
                    const int tok0 = grp * 64 + F.wave * 8;
#pragma unroll 1
                    for (int tt0 = 0; tt0 < 8; tt0 += 2) {
                        v2u xw_[2][4];
#pragma unroll
                        for (int r = 0; r < 2; ++r) { const GAS v2u* xr = (const GAS v2u*)(xo + (size_t)(tok0 + tt0 + r) * DM) + F.lane;
#pragma unroll
                            for (int j = 0; j < 4; ++j) xw_[r][j] = xr[64 * j]; }
#pragma unroll
                        for (int r = 0; r < 2; ++r) { const int tt = tt0 + r, tok = tok0 + tt;
                        float s = 0.f, lg[8];
#pragma unroll
                        for (int e = 0; e < 8; ++e) lg[e] = 0.f;
#pragma unroll
                        for (int j = 0; j < 4; ++j) { const v2u w = xw_[r][j]; const f32x4 v = {bflo(w.x), bfhi(w.x), bflo(w.y), bfhi(w.y)}; s += (v[0] * v[0] + v[1] * v[1]) + (v[2] * v[2] + v[3] * v[3]);
#pragma unroll
                            for (int i = 0; i < 4; ++i)
#pragma unroll
                                for (int e = 0; e < 8; ++e) lg[e] += v[i] * gr[j * 4 + i][e]; }
                        s = wave_sum(s);
#pragma unroll
                        for (int e = 0; e < 8; ++e) lg[e] = wave_sum(lg[e]);
                        const float rstd = 1.0f / sqrtf(s * (1.0f / DM) + EPS);
                        int e0 = 0; float v0 = lg[0];
#pragma unroll
                        for (int e = 1; e < 8; ++e) if (lg[e] > v0) { v0 = lg[e]; e0 = e; }
                        int e1 = -1; float v1 = -INFINITY;
#pragma unroll
                        for (int e = 0; e < 8; ++e) if (e != e0 && lg[e] > v1) { v1 = lg[e]; e1 = e; }
                        const float w0 = 1.0f / (1.0f + expf((v1 - v0) * rstd));
                        if (F.lane == 0) { const int li = F.wave * 8 + tt; sE[li * 2] = e0; sE[li * 2 + 1] = e1; sW[li * 2] = w0; sW[li * 2 + 1] = 1.0f - w0; RSTD1[tok] = rstd; }
                        }
                    }
                    LDS_WAIT(); __syncthreads();
                    if (F.wave == 0) {
                        const int tok = grp * 64 + F.lane; const int e0 = sE[F.lane * 2], e1 = sE[F.lane * 2 + 1];
                        const unsigned long long lt = (1ull << F.lane) - 1ull;
                        int p0 = 0, p1 = 0;
#pragma unroll
                        for (int e = 0; e < 8; ++e) { const unsigned long long m0 = __ballot(e0 == e), m1 = __ballot(e1 == e);
                            const unsigned c = (unsigned)(__popcll(m0) + __popcll(m1)); unsigned b0 = 0u;
                            if (F.lane == 0 && c) b0 = __hip_atomic_fetch_add(CNT + e, c, RLX_AGENT);
                            b0 = (unsigned)__builtin_amdgcn_readfirstlane(b0);
                            if (e0 == e) p0 = (int)b0 + __popcll(m0 & lt);
                            if (e1 == e) p1 = (int)b0 + __popcll(m0) + __popcll(m1 & lt); }
                        LIST[e0 * M + p0] = tok; LIST[e1 * M + p1] = tok;
                        TOPE[tok * 2] = e0; TOPE[tok * 2 + 1] = e1; TOPP[tok * 2] = p0; TOPP[tok * 2 + 1] = p1; TOPW[tok * 2] = sW[F.lane * 2]; TOPW[tok * 2 + 1] = sW[F.lane * 2 + 1];
                    }
                    __syncthreads();
                }
            }
#endif
            GRID_BAR();
#ifndef SKIP_PMU
            for (int repm_ = 0; repm_ < DUPM; ++repm_) {
                PHASE_BEGIN();
                MOE_TABLE();
                { pg8::Gemm g{WSP(bf16, WS_X1B), WSP(bf16, WS_WGUE), DM, DM}; pg8::MoeOrderT<true> S; S.init((const LAS int*)(F.lds + MOETAB_OFF), 2 * DFFE, (unsigned)(2 * DFFE * DM * 2), GRID, bid, MOE_NEARLY());
                  pg8::EpiUpT<true> E{WSP(bf16, WS_HMOE), DFFE, (unsigned*)(ws + WS_CTL) + CW_RDY}; pg8::RsGather R{WSP(float, WS_RSTD1), WSP(int, WS_LIST)};
                  pg8::gemm_phase<pg8::EpiUpT<true>, pg8::MoeOrderT<true>, pg8::RsGather, true, true>(F.wave, F.lds + RING_OFF, rsb, g, S, E, R, WSP(int, WS_LIST), 0); }
#ifndef NO_EARLY_DOWN
                { const int nearly = MOE_NEARLY(); const int j = GRID - 1 - bid;
                  if (j < nearly) {
                    if (F.tid == 0) { unsigned* bar_ = (unsigned*)(ws + WS_CTL) + CW_BAR; unsigned* rdy_ = (unsigned*)(ws + WS_CTL) + CW_RDY; XB_SPIN(xb_ld(rdy_) < 88u * NWAVES, bar_); }
                    __syncthreads();
                    __builtin_amdgcn_fence(__ATOMIC_ACQUIRE, "agent");
                    pg8::Gemm g{WSP(bf16, WS_HMOE), WSP(bf16, WS_WDE), DFFE, DFFE}; pg8::MoeOne S; S.O.init((const LAS int*)(F.lds + MOETAB_OFF), DM, (unsigned)(DM * DFFE * 2), GRID, bid); S.wg = j;
                    pg8::EpiY E{WSP(bf16, WS_Y)}; pg8::RsNone R;
                    pg8::gemm_phase<pg8::EpiY, pg8::MoeOne, pg8::RsNone, false, true>(F.wave, F.lds + RING_OFF, rsb, g, S, E, R, nullptr, 0);
                  } }
#endif
            }
#endif
            GRID_BAR_WT();
#ifndef SKIP_PMD
            for (int repm_ = 0; repm_ < DUPM; ++repm_) {
                PHASE_BEGIN();
                MOE_TABLE();
                pg8::Gemm g{WSP(bf16, WS_HMOE), WSP(bf16, WS_WDE), DFFE, DFFE}; pg8::MoeOrder S; S.init((const LAS int*)(F.lds + MOETAB_OFF), DM, (unsigned)(DM * DFFE * 2), GRID, bid, MOE_NEARLY());
                pg8::EpiY E{WSP(bf16, WS_Y)}; pg8::RsNone R;
                pg8::gemm_phase<pg8::EpiY, pg8::MoeOrder, pg8::RsNone, false, true>(F.wave, F.lds + RING_OFF, rsb, g, S, E, R, nullptr, 0);
            }
#endif
            GRID_BAR_WT();
#ifndef SKIP_PF
            {
                PHASE_BEGIN();
                unsigned* CNT = (unsigned*)(ws + WS_CTL) + CW_CNT;
                LAS int* tbl = (LAS int*)(F.lds + RING_OFF);
                if (F.tid == 0) { int t = 0; for (int j = 0; j < NE; ++j) { tbl[j] = t; t += ((int)__hip_atomic_load(CNT + j, RLX_AGENT) + 255) / 256; } }
                LDS_WAIT(); __syncthreads();
                const int* TOPE = WSP(int, WS_TOPE); const float* TOPW = WSP(float, WS_TOPW); const int* TOPP = WSP(int, WS_TOPP); const bf16* YB = WSP(bf16, WS_Y);
                float* out = ka->out; const float* fng = ka->final_norm; const bf16* X1 = WSP(bf16, WS_X1B);
                for (long mrow0 = gw; mrow0 < M; mrow0 += 2 * NGW) {
                    v2u xx[2][4], ya[2][4], yb[2][4]; float w0[2], w1[2];
#pragma unroll
                    for (int r = 0; r < 2; ++r) { const long mrow = mrow0 + r * NGW;
                        const int e0 = TOPE[mrow * 2], e1 = TOPE[mrow * 2 + 1]; w0[r] = TOPW[mrow * 2]; w1[r] = TOPW[mrow * 2 + 1];
                        const size_t s0 = (size_t)tbl[e0] * 256 + TOPP[mrow * 2], s1 = (size_t)tbl[e1] * 256 + TOPP[mrow * 2 + 1];
                        const GAS v2u* xr = (const GAS v2u*)(X1 + (size_t)mrow * DM) + F.lane;
                        const GAS v2u* y0 = (const GAS v2u*)(YB + s0 * DM) + F.lane; const GAS v2u* y1 = (const GAS v2u*)(YB + s1 * DM) + F.lane;
#pragma unroll
                        for (int j = 0; j < 4; ++j) { xx[r][j] = xr[64 * j]; ya[r][j] = y0[64 * j]; yb[r][j] = y1[64 * j]; } }
#pragma unroll
                    for (int r = 0; r < 2; ++r) { const long mrow = mrow0 + r * NGW; GAS f32x4* xw = (GAS f32x4*)(out + (size_t)mrow * DM) + F.lane;
                        f32x4 v[4]; float s = 0.f;
#pragma unroll
                        for (int j = 0; j < 4; ++j) { const v2u a0 = ya[r][j], a1 = yb[r][j], x0 = xx[r][j];
                            v[j][0] = bflo(x0.x) + w0[r] * bflo(a0.x) + w1[r] * bflo(a1.x); v[j][1] = bfhi(x0.x) + w0[r] * bfhi(a0.x) + w1[r] * bfhi(a1.x);
                            v[j][2] = bflo(x0.y) + w0[r] * bflo(a0.y) + w1[r] * bflo(a1.y); v[j][3] = bfhi(x0.y) + w0[r] * bfhi(a0.y) + w1[r] * bfhi(a1.y);
                            s += (v[j][0] * v[j][0] + v[j][1] * v[j][1]) + (v[j][2] * v[j][2] + v[j][3] * v[j][3]); }
                        s = wave_sum(s); const float rstd = 1.0f / sqrtf(s * (1.0f / DM) + EPS);
#pragma unroll
                        for (int j = 0; j < 4; ++j) { const f32x4 gn = *((const f32x4*)fng + F.lane + 64 * j); xw[64 * j] = v[j] * rstd * gn; } }
                }
            }
#endif
        }
    }
}


extern "C" void kernel_launch(void* const* d_in, const int* in_sizes, int n_in, void* d_out, int out_size, void* d_ws, size_t ws_size, hipStream_t stream) {
    static int grid = 0;
    if (grid == 0) {
        if (n_in != 21 || in_sizes[0] != M * DM || out_size != M * DM || ws_size < WS_END) { fprintf(stderr, "kernel_launch: unexpected problem (n_in %d, ws %zu < %zu?)\n", n_in, ws_size, (size_t)WS_END); grid = -1; return; }
        int dev = 0, cus = 0;
        if (hipGetDevice(&dev) != hipSuccess || hipDeviceGetAttribute(&cus, hipDeviceAttributeMultiprocessorCount, dev) != hipSuccess) { grid = -1; return; }
        if (hipFuncSetAttribute((const void*)trunk_fwd, hipFuncAttributeMaxDynamicSharedMemorySize, LDS_BYTES) != hipSuccess) { fprintf(stderr, "kernel_launch: hipFuncSetAttribute failed\n"); grid = -1; return; }
        int per_cu = 0;
        (void)hipOccupancyMaxActiveBlocksPerMultiprocessor(&per_cu, (const void*)trunk_fwd, NWAVES * 64, LDS_BYTES);
        (void)hipGetLastError();
        if (cus < GRID || per_cu < 1) { fprintf(stderr, "kernel_launch: needs %d resident workgroups (cus %d, per_cu %d)\n", GRID, cus, per_cu); }
        grid = GRID;
    }
    if (grid < 0) return;
    (void)hipMemsetAsync((char*)d_ws + WS_CTL, 0, CTL_ZERO_BYTES, stream);
    Args a{};
    a.x = (const float*)d_in[0]; a.pos = (const int*)d_in[1]; a.attn_norm = (const float*)d_in[2]; a.w_in = (const float*)d_in[3]; a.conv_w = (const float*)d_in[4];
    a.w_conv_out = (const float*)d_in[5]; a.q_norm = (const float*)d_in[6]; a.w_uq = (const float*)d_in[7]; a.kv_norm = (const float*)d_in[8]; a.w_ukv = (const float*)d_in[9];
    a.w_mla_out = (const float*)d_in[10]; a.w_o = (const float*)d_in[11]; a.ffn_norm = (const float*)d_in[12]; a.w_gate = (const float*)d_in[13]; a.w_up = (const float*)d_in[14];
    a.w_down = (const float*)d_in[15]; a.router = (const float*)d_in[16]; a.w_gate_e = (const float*)d_in[17]; a.w_up_e = (const float*)d_in[18]; a.w_down_e = (const float*)d_in[19];
    a.final_norm = (const float*)d_in[20]; a.out = (float*)d_out; a.ws = (unsigned char*)d_ws;
    hipLaunchKernelGGL(trunk_fwd, dim3(grid), dim3(NWAVES * 64), LDS_BYTES, stream, a);
}
```

```cpp
#include <hip/hip_runtime.h>
#ifndef DUP3
#define DUP3 1
#endif
#ifndef DUPE
#define DUPE 1
#endif
#ifndef DUPC
#define DUPC 1
#endif
#ifndef DUP5
#define DUP5 1
#endif
#ifndef DUP7
#define DUP7 1
#endif
#ifndef DUPB
#define DUPB 1
#endif
#ifndef DUP2
#define DUP2 1
#endif
#ifndef DUP4
#define DUP4 1
#endif
#ifndef DUP0
#define DUP0 1
#endif
#ifndef DUP1
#define DUP1 1
#endif
#ifndef DUP6
#define DUP6 1
#endif
#ifndef DUPM
#define DUPM 1
#endif
#include <hip/hip_bf16.h>
#include <cstdio>
#include <cstdint>
#include <cmath>

constexpr int BATCH = 8, SEQ = 2048, DM = 1024, M = BATCH * SEQ;
constexpr int DCONV = 512, QLORA = 384, KVLORA = 256, NH = 8, DQK = 96, DVH = 64;
constexpr int DIN = 4256, DINP = 4352;
constexpr int DFF = 2816, NE = 8, DFFE = 1408;
constexpr float EPS = 1e-6f;
constexpr float QSCALE = 0.10206207261596577f * 1.4426950408889634f;

#define GAS __attribute__((address_space(1)))
#define LAS __attribute__((address_space(3)))
typedef unsigned short bf16;
typedef unsigned v4u __attribute__((ext_vector_type(4)));
typedef unsigned v2u __attribute__((ext_vector_type(2)));
typedef float f32x4 __attribute__((ext_vector_type(4)));
typedef float f32x2 __attribute__((ext_vector_type(2)));
typedef short bf16x8 __attribute__((ext_vector_type(8)));
typedef GAS unsigned gu32;

__device__ __forceinline__ int fresh_lane() { int l; asm volatile("v_mbcnt_lo_u32_b32 %0, -1, 0\n\tv_mbcnt_hi_u32_b32 %0, -1, %0" : "=v"(l)); return l; }
template <int MASK> __device__ __forceinline__ float swz_xor(float v) { return __builtin_bit_cast(float, __builtin_amdgcn_ds_swizzle(__builtin_bit_cast(int, v), (MASK << 10) | 0x1f)); }
__device__ __forceinline__ float xadd32(float v) { auto rr = __builtin_amdgcn_permlane32_swap(__float_as_uint(v), __float_as_uint(v), false, false); return __uint_as_float(rr[0]) + __uint_as_float(rr[1]); }
__device__ __forceinline__ float xadd_16_32(float q) { q += swz_xor<16>(q); return xadd32(q); }
typedef __bf16 bf16x2_t __attribute__((ext_vector_type(2)));
__device__ __forceinline__ unsigned cvt_pk_bf16(float lo, float hi) { const f32x2 v = {lo, hi}; const bf16x2_t b = __builtin_convertvector(v, bf16x2_t); return __builtin_bit_cast(unsigned, b); }
__device__ __forceinline__ float bflo(unsigned w) { return __uint_as_float(w << 16); }
__device__ __forceinline__ float bfhi(unsigned w) { return __uint_as_float(w & 0xffff0000u); }
__device__ __forceinline__ v4u pack8(const f32x4 a, const f32x4 b) { v4u w; w.x = cvt_pk_bf16(a[0], a[1]); w.y = cvt_pk_bf16(a[2], a[3]); w.z = cvt_pk_bf16(b[0], b[1]); w.w = cvt_pk_bf16(b[2], b[3]); return w; }
__device__ __forceinline__ void unpack8(const v4u w, f32x4& a, f32x4& b) { a = (f32x4){bflo(w.x), bfhi(w.x), bflo(w.y), bfhi(w.y)}; b = (f32x4){bflo(w.z), bfhi(w.z), bflo(w.w), bfhi(w.w)}; }
__device__ __forceinline__ float sigmoidf_(float v) { return __builtin_amdgcn_rcpf(1.0f + __builtin_amdgcn_exp2f(-1.4426950408889634f * v)); }

constexpr size_t MiB = 1u << 20;
constexpr size_t WS_CTL = 0, CTL_ZERO_BYTES = 64 * 1024;
constexpr size_t WS_PART = 1 * MiB;
constexpr size_t WS_SSQQ = 2 * MiB;
constexpr size_t WS_SSQKV = 2 * MiB + 512 * 1024;
constexpr size_t WS_RSTD1 = 2 * MiB + 768 * 1024;
constexpr size_t WS_COS = 3 * MiB, WS_SIN = 4 * MiB;
constexpr size_t WS_TOPE = 5 * MiB, WS_TOPW = 5 * MiB + 128 * 1024, WS_TOPP = 5 * MiB + 256 * 1024;
constexpr size_t WS_LIST = 5 * MiB + 512 * 1024;
constexpr size_t WS_W = 7 * MiB;
constexpr size_t W_IN_EL = (size_t)DINP * DM, W_UQ_EL = 768 * 384, W_UKV_EL = 1024 * 256, W_CM_EL = 1024 * 512, W_O_EL = 1024 * 1024;
constexpr size_t WO_IN = 0, WO_UQ = WO_IN + 2 * W_IN_EL, WO_UKV = WO_UQ + 2 * W_UQ_EL, WO_C = WO_UKV + 2 * W_UKV_EL, WO_M = WO_C + 2 * W_CM_EL,
                 WO_O = WO_M + 2 * W_CM_EL, WO_GU = WO_O + 2 * W_O_EL, WO_D = WO_GU + (size_t)2 * DFF * DM, WO_END = WO_D + (size_t)DM * DFF;
static_assert(WO_END * 2 <= 44 * MiB, "weights");
constexpr size_t WS_XB = 51 * MiB;
constexpr size_t WS_ACT = 83 * MiB;
constexpr size_t WS_CU = WS_ACT, WS_CQ = WS_CU + 16 * MiB, WS_CKV = WS_CQ + 12 * MiB, WS_ZATT = WS_CKV + 8 * MiB, WS_Q = WS_ZATT + 32 * MiB,
                 WS_K = WS_Q + 24 * MiB, WS_V = WS_K + 24 * MiB, WS_S1 = WS_V + 16 * MiB, WS_S2 = WS_S1 + 32 * MiB, WS_END = WS_S2 + 32 * MiB;
constexpr size_t WS_X1B = 246 * MiB;
constexpr size_t WS_TMP = WS_Q, WS_MERGED = WS_Q + 32 * MiB;
constexpr size_t WS_HD = WS_Q;
constexpr size_t WS_WGUE = WS_ACT, WS_WDE = WS_ACT + 44 * MiB;
constexpr size_t WS_HMOE = WS_Q;
constexpr size_t WS_Y = WS_W;
constexpr int MOE_ROWS = 2 * M + NE * 256;
static_assert(WS_HMOE + (size_t)MOE_ROWS * DFFE * 2 <= WS_END && WS_Y + (size_t)MOE_ROWS * DM * 2 <= WS_ACT && WS_WDE + (size_t)NE * DM * DFFE * 2 <= WS_Q, "moe map");
static_assert(WS_HD + (size_t)M * DFF * 2 <= WS_END, "dense hidden");
static_assert(WS_X1B >= WS_HMOE + (size_t)MOE_ROWS * DFFE * 2 && WS_X1B + (size_t)M * DM * 2 <= WS_END, "x1b");
constexpr int CW_BAR = 4096, CW_CNT = 256, CW_RDY = 320, CW_RDY2 = 384;

namespace pg8 {
#define PG8_LAS __attribute__((address_space(3)))
typedef unsigned short bf16_t;
constexpr int BM = 256, BK = 64, HALF = 128, HTB = HALF * BK * 2, STAGE_BYTES = 8 * HTB, NXCD = 8, WGM = 8;
__host__ __device__ __forceinline__ int lds_byte(int r, int c) { const int st = (r >> 4) * 2 + (c >> 5), rr = r & 15, cc = c & 31, ob = rr * 64 + cc * 2; return st * 1024 + (ob ^ (((ob >> 9) & 1) << 5)); }
__host__ __device__ __forceinline__ void stage_rc(int b, int& R, int& C) { const int st = b / 1024, sb = b % 1024, swz = sb ^ (((sb >> 9) & 1) << 5); R = (st >> 1) * 16 + swz / 64; C = (st & 1) * 32 + (swz % 64) / 2; }
__host__ __device__ __forceinline__ int perm32(int rho) { const int n = rho >> 4, i = rho & 15; return 8 * (i >> 2) + 4 * n + (i & 3); }

struct Unit { int pm, pn; unsigned bo; int lo, gn; };
struct Gemm { const bf16_t* A; const bf16_t* Bt; int lda; int K; };

struct StaticOrder {
    int nM, nN, nwg, G, c;
    __device__ void init(int Mr, int N, int G_, int c_) { nM = Mr / BM; nN = N / BM; nwg = nM * nN; G = G_; c = c_; }
    __device__ bool next(int i, Unit& u) const {
        const long L = (long)i * G + c; if (L >= nwg) return false;
        int wgid = (int)L; { const int q = nwg / NXCD, r = nwg % NXCD, xcd = wgid % NXCD, off = wgid / NXCD; wgid = (xcd < r ? xcd * (q + 1) : r * (q + 1) + (xcd - r) * q) + off; }
        const int nig = WGM * nN, gid = wgid / nig, fm = gid * WGM, gsz = (nM - fm) < WGM ? (nM - fm) : WGM;
        u.pm = fm + ((wgid % nig) % gsz); u.pn = (wgid % nig) / gsz; u.bo = 0u; u.lo = 0; u.gn = 0; return true;
    }
};
struct OneTileOrder { int pm, pn; bool has;
    __device__ bool next(int i, Unit& u) const { if (i > 0 || !has) return false; u.pm = pm; u.pn = pn; u.bo = 0u; u.lo = 0; u.gn = 0; return true; } };
template <bool UP> struct MoeOrderT {
    int nM, nN, nwg, G, c, sk; const PG8_LAS int* tab; unsigned bstride;
    __device__ void init(const PG8_LAS int* tab_, int N, unsigned bstride_, int G_, int c_, int sk_ = 0) {
        tab = tab_; nM = __builtin_amdgcn_readfirstlane(tab_[NE]); nN = N / BM; sk = sk_; nwg = nM * nN - (UP ? 0 : sk_); G = G_; c = c_; bstride = bstride_;
    }
    __device__ __forceinline__ void tile(int wgid, Unit& u) const {
        const int nig = WGM * nN, gid = wgid / nig, fm = gid * WGM, gsz = (nM - fm) < WGM ? (nM - fm) : WGM;
        u.pm = fm + ((wgid % nig) % gsz); u.pn = (wgid % nig) / gsz;
        int e = 0;
#pragma unroll
        for (int j = 1; j < NE; ++j) if (u.pm >= __builtin_amdgcn_readfirstlane(tab[j])) e = j;
        const int t0 = __builtin_amdgcn_readfirstlane(tab[e]), n0 = __builtin_amdgcn_readfirstlane(tab[NE + 1 + e]);
        const int lt = u.pm - t0; u.bo = (unsigned)e * bstride; u.lo = e * M + lt * BM; u.gn = n0 - lt * BM;
    }
    __device__ bool next(int i, Unit& u) const {
        long L = (long)i * G + c;
        if constexpr (UP) { const int n6 = nwg - 5 * G;
            if (sk > 0 && n6 >= 0 && n6 + 2 * sk <= G && nwg <= 6 * G) {
                if (c >= G - sk) { if (i >= 4) return false; }
                else if (i == 5 && c >= n6) { if (c - n6 >= sk) return false; L = 5L * G - sk + (c - n6); } } }
        if (L >= nwg) return false;
        int wgid = (int)L; { const int q = nwg / NXCD, r = nwg % NXCD, xcd = wgid % NXCD, off = wgid / NXCD; wgid = (xcd < r ? xcd * (q + 1) : r * (q + 1) + (xcd - r) * q) + off; }
        tile(wgid + (UP ? 0 : sk), u); return true;
    }
};
typedef MoeOrderT<false> MoeOrder;
struct MoeOne { MoeOrder O; int wg;
    __device__ bool next(int i, Unit& u) const { if (i > 0) return false; O.tile(wg, u); return true; } };

struct RsNone { struct Regs {}; __device__ __forceinline__ Regs pre(const Unit&, int) const { return {}; } __device__ __forceinline__ void post(PG8_LAS float*, const Regs&, int) const {} };
template <int NP> struct RsPart {
    const float* part; float inv_n;
    struct Regs { f32x4 v[NP / 4]; };
    __device__ __forceinline__ Regs pre(const Unit& u, int tid) const { Regs r;
#pragma unroll
        for (int j = 0; j < NP / 4; ++j) r.v[j] = (f32x4){0.f, 0.f, 0.f, 0.f};
        if (tid < 256) { const f32x4* p = (const f32x4*)(part + (size_t)(u.pm * BM + tid) * NP);
#pragma unroll
            for (int j = 0; j < NP / 4; ++j) r.v[j] = p[j]; }
        return r; }
    __device__ __forceinline__ void post(PG8_LAS float* dst, const Regs& r, int tid) const {
        if (tid < 256) { float s = 0.f;
#pragma unroll
            for (int j = 0; j < NP / 4; ++j) s += (r.v[j][0] + r.v[j][1]) + (r.v[j][2] + r.v[j][3]);
            dst[tid] = 1.0f / sqrtf(s * inv_n + EPS); } }
};
struct RsGather {
    const float* rstd; const int* list;
    struct Regs { float v; };
    __device__ __forceinline__ Regs pre(const Unit& u, int tid) const { Regs r; r.v = (tid < 256 && tid < u.gn) ? rstd[list[u.lo + tid]] : 0.f; return r; }
    __device__ __forceinline__ Regs pre_tok(int tok, const Unit& u, int tid) const { Regs r; r.v = (tid < 256 && tid < u.gn) ? rstd[tok] : 0.f; return r; }
    __device__ __forceinline__ void post(PG8_LAS float* dst, const Regs& r, int tid) const { if (tid < 256) dst[tid] = r.v; }
};

__device__ __forceinline__ void st16(bf16_t* base, size_t off, v4u w) {
#ifdef NO_WT_STORES
    *(v4u*)(base + off) = w;
#else
    __builtin_amdgcn_raw_buffer_store_b128(w, __builtin_amdgcn_make_buffer_rsrc((void*)base, 0, 0x7fffffff, 0x00020000), (int)(unsigned)(off * 2), 0, 16);
#endif
}
__device__ __forceinline__ void st_wt(float* p, float v) { __hip_atomic_store(p, v, __ATOMIC_RELAXED, __HIP_MEMORY_SCOPE_AGENT); }
#define EPI_ARGS const f32x4 (&acc)[2][2][4][2], const Unit& u, int wr, int wc, int fr, int fq, const PG8_LAS float* rs
#define EPI_FOR_ROWS _Pragma("unroll") for (int ai = 0; ai < 2; ++ai) _Pragma("unroll") for (int m = 0; m < 4; ++m)
#define EPI_LR (ai * HALF + wr * 64 + m * 16 + fr)

struct EpiIn {
    unsigned char* ws;
    __device__ __forceinline__ void operator()(EPI_ARGS) const {
        bf16_t* const CU = (bf16_t*)(ws + WS_CU); bf16_t* const ZB = (bf16_t*)(ws + WS_ZATT); bf16_t* const CQ = (bf16_t*)(ws + WS_CQ); bf16_t* const CKV = (bf16_t*)(ws + WS_CKV);
        bf16_t* const KB = (bf16_t*)(ws + WS_K); bf16_t* const S1 = (bf16_t*)(ws + WS_S1); bf16_t* const S2 = (bf16_t*)(ws + WS_S2);
        float* const SSQQ = (float*)(ws + WS_SSQQ); float* const SSQKV = (float*)(ws + WS_SSQKV); const float* const COS = (const float*)(ws + WS_COS); const float* const SIN = (const float*)(ws + WS_SIN);
        const int pn = u.pn, cw = wc * 32 + 8 * fq;
        if (pn < 4) {
            EPI_FOR_ROWS { const int lr = EPI_LR; const size_t row = (size_t)u.pm * BM + lr; const float s = rs[lr], s2 = s * s;
                const f32x4 a = acc[ai][0][m][0] * acc[ai][1][m][0] * s2, b = acc[ai][0][m][1] * acc[ai][1][m][1] * s2;
                st16(CU, row * DCONV + pn * 128 + cw, pack8(a, b)); }
        } else if (pn < 6) {
            EPI_FOR_ROWS { const int lr = EPI_LR; const size_t row = (size_t)u.pm * BM + lr; const float s = rs[lr];
#pragma unroll
                for (int bj = 0; bj < 2; ++bj) st16(ZB, row * 1024 + (pn - 4) * 256 + bj * HALF + cw, pack8(acc[ai][bj][m][0] * s, acc[ai][bj][m][1] * s)); }
        } else if (pn == 6 || pn == 8) {
            bf16_t* O = pn == 6 ? CQ : CKV; const int ld = pn == 6 ? QLORA : KVLORA; float* SQ = pn == 6 ? SSQQ : SSQKV; const int np = pn == 6 ? 8 : 4;
            EPI_FOR_ROWS { const int lr = EPI_LR; const size_t row = (size_t)u.pm * BM + lr; const float s = rs[lr]; float q = 0.f;
#pragma unroll
                for (int bj = 0; bj < 2; ++bj) { const f32x4 a = acc[ai][bj][m][0] * s, b = acc[ai][bj][m][1] * s;
                    q += (a[0] * a[0] + a[1] * a[1]) + (a[2] * a[2] + a[3] * a[3]) + (b[0] * b[0] + b[1] * b[1]) + (b[2] * b[2] + b[3] * b[3]);
                    st16(O, row * ld + bj * HALF + cw, pack8(a, b)); }
                q = xadd_16_32(q);
                if (fq == 0) SQ[row * np + wc] = q; }
        } else if (pn == 7) {
            EPI_FOR_ROWS { const int lr = EPI_LR; const size_t row = (size_t)u.pm * BM + lr; const float s = rs[lr];
                const f32x4 a = acc[ai][0][m][0] * s, b = acc[ai][0][m][1] * s;
                float q = (a[0] * a[0] + a[1] * a[1]) + (a[2] * a[2] + a[3] * a[3]) + (b[0] * b[0] + b[1] * b[1]) + (b[2] * b[2] + b[3] * b[3]);
                st16(CQ, row * QLORA + 256 + cw, pack8(a, b));
                q = xadd_16_32(q);
                if (fq == 0) SSQQ[row * 8 + 4 + wc] = q; }
            if (wc == 0) {
#pragma unroll
                for (int ai = 0; ai < 2; ++ai) { f32x4 cc[4], ss[4];
#pragma unroll
                    for (int m = 0; m < 4; ++m) { const size_t row = (size_t)u.pm * BM + EPI_LR; cc[m] = *(const f32x4*)(COS + row * 16 + 4 * fq); ss[m] = *(const f32x4*)(SIN + row * 16 + 4 * fq); }
#pragma unroll
                    for (int m = 0; m < 4; ++m) { const int lr = EPI_LR; const size_t row = (size_t)u.pm * BM + lr; const float s = rs[lr];
                        const f32x4 x1 = acc[ai][1][m][0] * s, x2 = acc[ai][1][m][1] * s;
                        const v4u w = pack8(x1 * cc[m] - x2 * ss[m], x2 * cc[m] + x1 * ss[m]);
#pragma unroll
                        for (int h = 0; h < NH; ++h) st16(KB, row * 768 + h * DQK + 64 + 8 * fq, w); }
                    asm volatile("" ::: "memory"); } }
        } else {
            const int t = pn - 9;
            EPI_FOR_ROWS { const int lr = EPI_LR; const size_t row = (size_t)u.pm * BM + lr; const float s = rs[lr]; f32x4 rr[2], ss[2];
#pragma unroll
                for (int n = 0; n < 2; ++n) { const f32x4 gc = acc[ai][0][m][n] * s, gm = acc[ai][1][m][n] * s; f32x4 r, s2;
#pragma unroll
                    for (int j = 0; j < 4; ++j) { const float ec = __builtin_amdgcn_exp2f(-1.4426950408889634f * gc[j]), em = __builtin_amdgcn_exp2f(-1.4426950408889634f * gm[j]);
                        s2[j] = __builtin_amdgcn_rcpf(1.0f + em); r[j] = (1.0f + em) * __builtin_amdgcn_rcpf(1.0f + ec); }
                    rr[n] = r; ss[n] = s2; }
                st16(S1, row * 1024 + t * 128 + cw, pack8(rr[0], rr[1])); st16(S2, row * 1024 + t * 128 + cw, pack8(ss[0], ss[1])); }
        }
    }
};
struct EpiQ {
    bf16_t* Q; const float *COS, *SIN, *SSQ;
    __device__ __forceinline__ void operator()(EPI_ARGS) const {
        const int cw = wc * 32 + 8 * fq; float sv[2][4];
        EPI_FOR_ROWS sv[ai][m] = QSCALE * rs[EPI_LR];
        asm volatile("" ::: "memory");
        const int rb = (u.pn * 8 + wc) % 3;
#pragma unroll
        for (int g2 = 0; g2 < 4; ++g2) { f32x4 cc[2], ss[2];
            if (rb != 0) {
#pragma unroll
                for (int j = 0; j < 2; ++j) { const int ai = g2 >> 1, m = (g2 & 1) * 2 + j; const size_t row = (size_t)u.pm * BM + EPI_LR; cc[j] = *(const f32x4*)(COS + row * 16 + 4 * fq); ss[j] = *(const f32x4*)(SIN + row * 16 + 4 * fq); } }
#pragma unroll
            for (int j = 0; j < 2; ++j) { const int ai = g2 >> 1, m = (g2 & 1) * 2 + j; const int lr = EPI_LR; const size_t row = (size_t)u.pm * BM + lr; const float s = sv[ai][m];
#pragma unroll
                for (int bj = 0; bj < 2; ++bj) { f32x4 a = acc[ai][bj][m][0] * s, b = acc[ai][bj][m][1] * s;
                    if ((rb + bj) % 3 == 2) { const f32x4 x1 = a, x2 = b; a = x1 * cc[j] - x2 * ss[j]; b = x2 * cc[j] + x1 * ss[j]; }
                    st16(Q, row * 768 + u.pn * 256 + bj * HALF + cw, pack8(a, b)); } }
            asm volatile("" ::: "memory"); }
    }
};
struct EpiKV {
    bf16_t *KB, *VB; const float* SSQ;
    __device__ __forceinline__ void operator()(EPI_ARGS) const {
        float sv[2][4];
        EPI_FOR_ROWS sv[ai][m] = rs[EPI_LR];
        EPI_FOR_ROWS { const int lr = EPI_LR; const size_t row = (size_t)u.pm * BM + lr; const float s = sv[ai][m];
#pragma unroll
            for (int bj = 0; bj < 2; ++bj) { const int h = u.pn * 2 + bj; const v4u w = pack8(acc[ai][bj][m][0] * s, acc[ai][bj][m][1] * s);
                if (wc < 2) st16(KB, row * 768 + h * DQK + wc * 32 + 8 * fq, w); else st16(VB, row * 512 + h * DVH + (wc - 2) * 32 + 8 * fq, w); } }
    }
};
struct EpiMerge {
    static constexpr int HOOK_T = 8;
    const bf16_t* Rm; const bf16_t* S2; bf16_t* O;
    __device__ __forceinline__ void mid(f32x4 (&acc)[2][2][4][2], const Unit& u, int wr, int wc, int fr, int fq) const {
        const int cw = wc * 32 + 8 * fq; v4u g[2][4][2];
        EPI_FOR_ROWS {
#pragma unroll
            for (int bj = 0; bj < 2; ++bj) g[ai][m][bj] = __builtin_nontemporal_load((const v4u*)(Rm + ((size_t)u.pm * BM + EPI_LR) * 1024 + u.pn * 256 + bj * HALF + cw)); }
        EPI_FOR_ROWS {
#pragma unroll
            for (int bj = 0; bj < 2; ++bj) { f32x4 ga, gb; unpack8(g[ai][m][bj], ga, gb); acc[ai][bj][m][0] *= ga; acc[ai][bj][m][1] *= gb; } }
    }
    __device__ __forceinline__ void operator()(EPI_ARGS) const {
        const int cw = wc * 32 + 8 * fq; v4u g[2][4][2];
        EPI_FOR_ROWS {
#pragma unroll
            for (int bj = 0; bj < 2; ++bj) g[ai][m][bj] = __builtin_nontemporal_load((const v4u*)(S2 + ((size_t)u.pm * BM + EPI_LR) * 1024 + u.pn * 256 + bj * HALF + cw)); }
        EPI_FOR_ROWS {
#pragma unroll
            for (int bj = 0; bj < 2; ++bj) { f32x4 ga, gb; unpack8(g[ai][m][bj], ga, gb);
                st16(O, ((size_t)u.pm * BM + EPI_LR) * 1024 + u.pn * 256 + bj * HALF + cw, pack8(acc[ai][bj][m][0] * ga, acc[ai][bj][m][1] * gb)); } }
    }
};
template <bool SIG> struct EpiRes {
    const void* XR; bf16_t* XO; float* PART;
    __device__ __forceinline__ void operator()(EPI_ARGS) const {
        const int cw = wc * 32 + 8 * fq;
#pragma unroll
        for (int ai = 0; ai < 2; ++ai) {
            f32x4 xa[4][2], xb[4][2];
#pragma unroll
            for (int m = 0; m < 4; ++m)
#pragma unroll
                for (int bj = 0; bj < 2; ++bj) { const size_t off = ((size_t)u.pm * BM + EPI_LR) * 1024 + u.pn * 256 + bj * HALF + cw;
                    unpack8(__builtin_nontemporal_load((const v4u*)((const bf16_t*)XR + off)), xa[m][bj], xb[m][bj]); }
#pragma unroll
            for (int m = 0; m < 4; ++m) { const size_t row = (size_t)u.pm * BM + EPI_LR; float q = 0.f;
#pragma unroll
                for (int bj = 0; bj < 2; ++bj) { const size_t off = row * 1024 + u.pn * 256 + bj * HALF + cw;
                    const f32x4 a = xa[m][bj] + acc[ai][bj][m][0], b = xb[m][bj] + acc[ai][bj][m][1];
                    q += (a[0] * a[0] + a[1] * a[1]) + (a[2] * a[2] + a[3] * a[3]) + (b[0] * b[0] + b[1] * b[1]) + (b[2] * b[2] + b[3] * b[3]);
                    st16(XO, off, pack8(a, b)); }
                q = xadd_16_32(q);
                if (fq == 0) PART[row * 16 + u.pn * 4 + wc] = q; }
            asm volatile("" ::: "memory");
        }
    }
};
template <bool SIG> struct EpiUpT {
    bf16_t* H; int ldh; unsigned* rdy;
    __device__ __forceinline__ void operator()(EPI_ARGS) const {
        const int cw = wc * 32 + 8 * fq;
        EPI_FOR_ROWS { const int lr = EPI_LR; const size_t row = (size_t)u.pm * BM + lr; const float s = rs[lr];
            f32x4 o[2];
#pragma unroll
            for (int n = 0; n < 2; ++n) { const f32x4 g = acc[ai][0][m][n] * s, up = acc[ai][1][m][n] * s;
#pragma unroll
                for (int j = 0; j < 4; ++j) o[n][j] = g[j] * sigmoidf_(g[j]) * up[j]; }
            st16(H, row * ldh + u.pn * 128 + cw, pack8(o[0], o[1])); }
        if constexpr (SIG) { if (u.pm < 8) {
            asm volatile("s_waitcnt vmcnt(0)" ::: "memory");
            if ((fr | fq) == 0) (void)__hip_atomic_fetch_add(rdy, 1u, __ATOMIC_RELAXED, __HIP_MEMORY_SCOPE_AGENT); } }
    }
};
typedef EpiUpT<false> EpiUp;
struct EpiY {
    bf16_t* Y;
    __device__ __forceinline__ void operator()(EPI_ARGS) const {
        const int cw = wc * 32 + 8 * fq;
        EPI_FOR_ROWS { const int lr = EPI_LR; const size_t row = (size_t)u.pm * BM + lr;
#pragma unroll
            for (int bj = 0; bj < 2; ++bj) st16(Y, row * 1024 + u.pn * 256 + bj * HALF + cw, pack8(acc[ai][bj][m][0], acc[ai][bj][m][1])); }
    }
};

template <class T, class = void> struct hook_t { static constexpr int v = 0; };
template <class T> struct hook_t<T, decltype((void)T::HOOK_T)> { static constexpr int v = T::HOOK_T; };
template <class Epi, class Sched, class RS, bool GATHER, bool ALIGN_EPI>
__device__ __forceinline__ void gemm_phase(int wave, PG8_LAS unsigned char* lds, PG8_LAS float* rsb, const Gemm g, const Sched& S, const Epi& E, const RS& RSC, const int* glist, int gn) {
    const int lane_ = fresh_lane(); int wid_ = wave; asm volatile("" : "+s"(wid_));
    const int wid = wid_, lane = lane_, tid = wid * 64 + lane, wr = wid >> 2, wc = wid & 3, fr = lane & 15, fq = lane >> 4;
    const int K = g.K, nt = K / BK, lda = g.lda;
    const __amdgpu_buffer_rsrc_t rA = __builtin_amdgcn_make_buffer_rsrc((void*)g.A, 0, 0x7fffffff, 0x00020000);
    const __amdgpu_buffer_rsrc_t rB = __builtin_amdgcn_make_buffer_rsrc((void*)g.Bt, 0, 0x7fffffff, 0x00020000);
    unsigned vB[2];
#pragma unroll
    for (int i = 0; i < 2; ++i) { int R_, C_; stage_rc(tid * 16 + i * 8192, R_, C_); const int Rb = (R_ & ~31) + perm32(R_ & 31); vB[i] = (unsigned)(Rb * K + C_) * 2u; }
    const unsigned kstep = (unsigned)(BK * 2);
    const unsigned hstepB = (unsigned)HALF * K * 2, tstepB = 2 * hstepB;
    const unsigned hstepA = (unsigned)HALF * lda * 2, tstepA = 2 * hstepA;
    const unsigned ldsw = (unsigned)wid * 1024u;
    const int aoff = lds_byte(wr * 64 + fr, fq * 8), boff = lds_byte(wc * 32 + fr, fq * 8);
#define PG8_SETA(v, un) do { _Pragma("unroll") for (int i_ = 0; i_ < 2; ++i_) { int R_, C_; stage_rc(tid * 16 + i_ * 8192, R_, C_); \
        if constexpr (GATHER) { _Pragma("unroll") for (int h_ = 0; h_ < 2; ++h_) { const int r_ = h_ * HALF + R_; const int tok_ = r_ < (un).gn ? glist[(un).lo + r_] : 0; v[h_][i_] = (unsigned)(tok_ * lda + C_) * 2u; } } \
        else { v[0][i_] = (unsigned)(R_ * lda + C_) * 2u; } } } while (0)
#define PG8_H1(off) (GATHER ? (off) : (off) + hstepA)
#define PG8_LDTOK(tk_, un) do { _Pragma("unroll") for (int i_ = 0; i_ < 2; ++i_) { int R_, C_; stage_rc(tid * 16 + i_ * 8192, R_, C_); (void)C_; \
        _Pragma("unroll") for (int h_ = 0; h_ < 2; ++h_) { const int r_ = h_ * HALF + R_; tk_[h_][i_] = r_ < (un).gn ? glist[(un).lo + r_] : 0; } } } while (0)
#define PG8_TOK2V(v, tk_) do { _Pragma("unroll") for (int i_ = 0; i_ < 2; ++i_) { int R_, C_; stage_rc(tid * 16 + i_ * 8192, R_, C_); (void)R_; \
        _Pragma("unroll") for (int h_ = 0; h_ < 2; ++h_) v[h_][i_] = (unsigned)(tk_[h_][i_] * lda + C_) * 2u; } } while (0)
#define PG8_SA(b, h) (((b) * 2 + (h)) * HTB)
#define PG8_SB(b, h) ((4 + (b) * 2 + (h)) * HTB)
#define PG8_STG(bufoff, rsrc, soff, o0, o1) do { \
        __builtin_amdgcn_raw_ptr_buffer_load_lds(rsrc, (PG8_LAS void*)(lds + (bufoff) + ldsw), 16, (int)(o0), (int)(soff), 0, 0); \
        __builtin_amdgcn_raw_ptr_buffer_load_lds(rsrc, (PG8_LAS void*)(lds + (bufoff) + ldsw + 8192), 16, (int)(o1), (int)(soff), 0, 0); } while (0)
#define PG8_LDA(dst, b, h) do { _Pragma("unroll") for (int m = 0; m < 4; ++m) _Pragma("unroll") for (int k = 0; k < 2; ++k) dst[m][k] = *(const PG8_LAS bf16x8*)(lds + PG8_SA(b, h) + aoff + m * 2048 + k * 1024); } while (0)
#define PG8_LDB(dst, b, h) do { _Pragma("unroll") for (int n = 0; n < 2; ++n) _Pragma("unroll") for (int k = 0; k < 2; ++k) dst[n][k] = *(const PG8_LAS bf16x8*)(lds + PG8_SB(b, h) + boff + n * 2048 + k * 1024); } while (0)
#define PG8_MMA(ai, bj, At, Bt) do { __builtin_amdgcn_s_setprio(1); _Pragma("unroll") for (int m = 0; m < 4; ++m) _Pragma("unroll") for (int n = 0; n < 2; ++n) _Pragma("unroll") for (int k = 0; k < 2; ++k) \
        acc[ai][bj][m][n] = __builtin_amdgcn_mfma_f32_16x16x32_bf16(Bt[n][k], At[m][k], acc[ai][bj][m][n], 0, 0, 0); __builtin_amdgcn_s_setprio(0); } while (0)
#define PG8_WAIT_V(n) asm volatile("s_waitcnt vmcnt(" #n ")" ::: "memory")
#define PG8_WAIT_L(n) asm volatile("s_waitcnt lgkmcnt(" #n ")" ::: "memory")
#define PG8_BAR __builtin_amdgcn_s_barrier()
#define PG8_SCHED __builtin_amdgcn_sched_barrier(0)
    Unit cur, nxt, nx2; int ui = 0; bool hn = false; int tk[GATHER ? 2 : 1][2]; int tkr = 0, tkru = 0;
    if (!S.next(0, cur)) return;
    f32x4 acc[2][2][4][2];
#pragma unroll
    for (int a = 0; a < 2; ++a)
#pragma unroll
        for (int b = 0; b < 2; ++b)
#pragma unroll
            for (int m = 0; m < 4; ++m)
#pragma unroll
                for (int n = 0; n < 2; ++n) acc[a][b][m][n] = (f32x4){0.f, 0.f, 0.f, 0.f};
    bf16x8 At[4][2], B0[2][2], B1[2][2];
    unsigned vA[GATHER ? 2 : 1][2], vN[GATHER ? 2 : 1][2];
    if constexpr (GATHER) { PG8_LDTOK(tk, cur); PG8_TOK2V(vA, tk); } else { PG8_SETA(vA, cur); }
    unsigned cA = GATHER ? 0u : (unsigned)cur.pm * tstepA, cB = (unsigned)cur.pn * tstepB + cur.bo;
    const auto r0_ = RSC.pre(cur, tid);
    PG8_STG(PG8_SB(0, 0), rB, cB, vB[0], vB[1]); PG8_STG(PG8_SB(0, 1), rB, cB + hstepB, vB[0], vB[1]); PG8_STG(PG8_SA(0, 0), rA, cA, vA[0][0], vA[0][1]); PG8_STG(PG8_SA(0, 1), rA, PG8_H1(cA), vA[GATHER ? 1 : 0][0], vA[GATHER ? 1 : 0][1]);
    RSC.post(rsb, r0_, tid);
    if (wr == 1) PG8_BAR;
    PG8_WAIT_V(2); PG8_BAR;
    PG8_STG(PG8_SB(1, 0), rB, cB + kstep, vB[0], vB[1]); PG8_STG(PG8_SA(1, 0), rA, cA + kstep, vA[0][0], vA[0][1]); PG8_STG(PG8_SB(1, 1), rB, cB + hstepB + kstep, vB[0], vB[1]);
    PG8_WAIT_V(6); PG8_BAR;
    if constexpr (GATHER) { hn = S.next(1, nxt); if (hn) { PG8_LDTOK(tk, nxt); tkr = (tid < 256 && tid < nxt.gn) ? glist[nxt.lo + tid] : 0; } }
    for (;;) {
        bool has_next, hn2 = false;
        if constexpr (GATHER) { has_next = hn; } else { has_next = S.next(ui + 1, nxt); }
        const unsigned nA = has_next ? (GATHER ? 0u : (unsigned)nxt.pm * tstepA) : cA, nB = has_next ? (unsigned)nxt.pn * tstepB + nxt.bo : cB;
        if constexpr (GATHER) { tkru = tkr; if (has_next) { PG8_TOK2V(vN, tk); } else {
#pragma unroll
            for (int h = 0; h < 2; ++h)
#pragma unroll
                for (int i = 0; i < 2; ++i) vN[h][i] = vA[h][i]; }
            hn2 = has_next && S.next(ui + 2, nx2); if (hn2) { PG8_LDTOK(tk, nx2); tkr = (tid < 256 && tid < nx2.gn) ? glist[nx2.lo + tid] : 0; } }
        typename RS::Regs rnext{};
        for (int t = 0; t < nt; t += 2) {
            const bool last = (t == nt - 2);
            if (last && has_next) { if constexpr (GATHER) rnext = RSC.pre_tok(tkru, nxt, wid * 64 + fresh_lane()); else rnext = RSC.pre(nxt, wid * 64 + fresh_lane()); }
            const unsigned a1 = cA + (unsigned)(t + 1) * kstep;
            const unsigned a2 = last ? nA : cA + (unsigned)(t + 2) * kstep, b2 = last ? nB : cB + (unsigned)(t + 2) * kstep;
            const unsigned a3 = a2 + kstep, b3 = b2 + kstep;
            unsigned x00 = vA[0][0], x01 = vA[0][1], x10 = vA[GATHER ? 1 : 0][0], x11 = vA[GATHER ? 1 : 0][1];
            if constexpr (GATHER) { if (last) { x00 = vN[0][0]; x01 = vN[0][1]; x10 = vN[1][0]; x11 = vN[1][1]; } }
            if constexpr (hook_t<Epi>::v > 0) { if (t == hook_t<Epi>::v) { const int l_m = fresh_lane(); E.mid(acc, cur, wr, wc, l_m & 15, l_m >> 4); } }
            PG8_LDB(B0, 0, 0); PG8_LDB(B1, 0, 1); PG8_SCHED; PG8_LDA(At, 0, 0); PG8_STG(PG8_SA(1, 1), rA, PG8_H1(a1), vA[GATHER ? 1 : 0][0], vA[GATHER ? 1 : 0][1]);
            PG8_WAIT_V(8); PG8_WAIT_L(0); PG8_BAR; PG8_MMA(0, 0, At, B0); PG8_MMA(0, 1, At, B1); PG8_BAR; PG8_SCHED;
            PG8_LDA(At, 0, 1); PG8_STG(PG8_SB(0, 0), rB, b2, vB[0], vB[1]); PG8_STG(PG8_SB(0, 1), rB, b2 + hstepB, vB[0], vB[1]); PG8_STG(PG8_SA(0, 0), rA, a2, x00, x01);
            PG8_WAIT_V(8); PG8_WAIT_L(0); PG8_BAR; PG8_MMA(1, 0, At, B0); PG8_MMA(1, 1, At, B1); PG8_BAR; PG8_SCHED;
            PG8_LDB(B0, 1, 0); PG8_LDB(B1, 1, 1); PG8_SCHED; PG8_LDA(At, 1, 0); PG8_STG(PG8_SA(0, 1), rA, PG8_H1(a2), x10, x11);
            PG8_WAIT_V(8); PG8_WAIT_L(0); PG8_BAR; PG8_MMA(0, 0, At, B0); PG8_MMA(0, 1, At, B1); PG8_BAR; PG8_SCHED;
            PG8_LDA(At, 1, 1); PG8_STG(PG8_SB(1, 0), rB, b3, vB[0], vB[1]); PG8_STG(PG8_SB(1, 1), rB, b3 + hstepB, vB[0], vB[1]); PG8_STG(PG8_SA(1, 0), rA, a3, x00, x01);
            PG8_WAIT_V(8); PG8_WAIT_L(0); PG8_BAR; PG8_MMA(1, 0, At, B0); PG8_MMA(1, 1, At, B1); PG8_BAR; PG8_SCHED;
        }
        if constexpr (ALIGN_EPI) { if (wr == 0) PG8_BAR; }
        { const int l_e = fresh_lane();
          E(acc, cur, wr, wc, l_e & 15, l_e >> 4, (const PG8_LAS float*)(rsb + (ui & 1) * 256));
          if (has_next) RSC.post(rsb + ((ui + 1) & 1) * 256, rnext, wid * 64 + l_e); }
        if (!has_next) break;
#pragma unroll
        for (int a = 0; a < 2; ++a)
#pragma unroll
            for (int b = 0; b < 2; ++b)
#pragma unroll
                for (int m = 0; m < 4; ++m)
#pragma unroll
                    for (int n = 0; n < 2; ++n) acc[a][b][m][n] = (f32x4){0.f, 0.f, 0.f, 0.f};
        cur = nxt; cA = nA; cB = nB; ++ui;
        if constexpr (GATHER) { nxt = nx2; hn = hn2;
#pragma unroll
            for (int h = 0; h < 2; ++h)
#pragma unroll
                for (int i = 0; i < 2; ++i) vA[h][i] = vN[h][i]; }
        if constexpr (ALIGN_EPI) { if (wr == 1) PG8_BAR; }
    }
    PG8_WAIT_V(0);
    if constexpr (!ALIGN_EPI) { if (wr == 0) PG8_BAR; }
    PG8_BAR;
#undef PG8_SETA
#undef PG8_LDTOK
#undef PG8_TOK2V
#undef PG8_H1
#undef PG8_SA
#undef PG8_SB
#undef PG8_STG
#undef PG8_LDA
#undef PG8_LDB
#undef PG8_MMA
#undef PG8_WAIT_V
#undef PG8_WAIT_L
#undef PG8_BAR
#undef PG8_SCHED
}
}

namespace att {
using f32x16 = __attribute__((ext_vector_type(16))) float;
using s16x4 = __attribute__((ext_vector_type(4))) short;
typedef short v4i16_t __attribute__((ext_vector_type(4)));
constexpr int QBR = 256, KVBLK = 64, QP = 768, KP = 768, VP = 512, OP = 1024;
constexpr int KSLOT = 12288, VSLOT = 8192, NSLOT = 2;
constexpr int LDS_K = 0, LDS_V = NSLOT * KSLOT, LDS_WS = LDS_V + NSLOT * VSLOT, LDS_OST = LDS_WS + 8 * 256, LDS_BYTES = LDS_OST + 8 * 4096;
__device__ __forceinline__ int crow(int r, int hi) { return (r & 3) + 8 * (r >> 2) + 4 * hi; }
__device__ __forceinline__ void glds16(const void* gsrc, unsigned lds_dst) { unsigned keep;
    asm volatile("s_mov_b32 %0, m0\n\ts_mov_b32 m0, %2\n\ts_nop 0\n\tglobal_load_lds_dwordx4 %1, off\n\ts_mov_b32 m0, %0" : "=&s"(keep) : "v"(gsrc), "s"(lds_dst) : "memory"); }
__device__ __forceinline__ void cmask(f32x16& p0, f32x16& p1, int jb, int qrel, int hi) {
    const float NEG = -INFINITY; const int kb = 64 * jb + 4 * hi;
#pragma unroll
    for (int r = 0; r < 16; ++r) { const int kv = kb + (r & 3) + 8 * (r >> 2); if (kv > qrel) p0[r] = NEG; if (kv + 32 > qrel) p1[r] = NEG; }
}
typedef __attribute__((address_space(3))) const char* lds_cptr;
__device__ __forceinline__ void qkt6(f32x16& p0, f32x16& p1, lds_cptr kslot, const bf16x8* qr, int r32, int hi) {
    lds_cptr kb = kslot + hi * 1024 + r32 * 16;
    p0 = f32x16{}; p1 = f32x16{};
#pragma unroll
    for (int d0 = 0; d0 < 6; ++d0) {
        const bf16x8 b0 = *(const LAS bf16x8*)(kb + d0 * 2048);
        const bf16x8 b1 = *(const LAS bf16x8*)(kb + d0 * 2048 + 512);
        p0 = __builtin_amdgcn_mfma_f32_32x32x16_bf16(b0, qr[d0], p0, 0, 0, 0); p1 = __builtin_amdgcn_mfma_f32_32x32x16_bf16(b1, qr[d0], p1, 0, 0, 0); }
}
__device__ __forceinline__ float rowmax(const f32x16& p0, const f32x16& p1) {
    float a = fmaxf(p0[0], p1[0]);
#pragma unroll
    for (int r = 1; r < 16; ++r) a = fmaxf(a, fmaxf(p0[r], p1[r]));
    auto rr = __builtin_amdgcn_permlane32_swap(__float_as_uint(a), __float_as_uint(a), false, false);
    return fmaxf(__uint_as_float(rr[0]), __uint_as_float(rr[1]));
}
__device__ __forceinline__ s16x4 vtr(lds_cptr p) { return __builtin_bit_cast(s16x4, __builtin_amdgcn_ds_read_tr16_b64_v4i16((LAS v4i16_t*)p)); }
__device__ __forceinline__ void pv(f32x16* o, lds_cptr vp, bf16x8 pa0, bf16x8 pa1, bf16x8 pa2, bf16x8 pa3) {
#pragma unroll
    for (int d0 = 0; d0 < 2; ++d0) { s16x4 lo[4], hi[4];
#pragma unroll
        for (int ks = 0; ks < 4; ++ks) { lo[ks] = vtr(vp + d0 * 4096 + ks * 1024); hi[ks] = vtr(vp + d0 * 4096 + ks * 1024 + 512); }
#define PK(k) (bf16x8){lo[k][0], lo[k][1], lo[k][2], lo[k][3], hi[k][0], hi[k][1], hi[k][2], hi[k][3]}
        o[d0] = __builtin_amdgcn_mfma_f32_32x32x16_bf16(pa0, PK(0), o[d0], 0, 0, 0);
        o[d0] = __builtin_amdgcn_mfma_f32_32x32x16_bf16(pa1, PK(1), o[d0], 0, 0, 0);
        o[d0] = __builtin_amdgcn_mfma_f32_32x32x16_bf16(pa2, PK(2), o[d0], 0, 0, 0);
        o[d0] = __builtin_amdgcn_mfma_f32_32x32x16_bf16(pa3, PK(3), o[d0], 0, 0, 0);
#undef PK
    }
}
constexpr int NSV = 3;
constexpr int L2_K = 0, L2_V = 2 * KSLOT, L2_WS = L2_V + NSV * VSLOT, L2_OST = L2_WS + 8 * 256, L2_BYTES = L2_OST + 8 * 4096;
constexpr float THR = 8.0f;
struct AttnState { float mrun, l_reg; f32x16 o[2]; bf16x8 qr[6]; };
__device__ __forceinline__ void attn_load_q(AttnState& st, const bf16* Qw, int r32, int hi) {
#pragma unroll
    for (int d0 = 0; d0 < 6; ++d0) st.qr[d0] = *reinterpret_cast<const bf16x8*>(&Qw[(long)r32 * QP + d0 * 16 + hi * 8]);
    asm volatile("" : "+v"(st.qr[0]), "+v"(st.qr[1]), "+v"(st.qr[2]), "+v"(st.qr[3]), "+v"(st.qr[4]), "+v"(st.qr[5]));
    st.mrun = -INFINITY; st.l_reg = 0.f; st.o[0] = f32x16{}; st.o[1] = f32x16{};
}
__device__ __forceinline__ void attn_scores(AttnState& st, v4u (&pw)[4], lds_cptr kslot, int t, int NT, int qrel, int r32, int hi, LAS float* wsf) {
    f32x16 p0, p1;
    qkt6(p0, p1, kslot, st.qr, r32, hi);
    if (t >= NT - 4) cmask(p0, p1, t - (NT - 4), qrel, hi);
    const float rm = rowmax(p0, p1);
    if (__any(rm - st.mrun > THR)) {
        const float mn = fmaxf(st.mrun, rm); const float alpha = __builtin_amdgcn_exp2f(st.mrun - mn);
        if (hi == 0) wsf[r32] = alpha;
        asm volatile("s_waitcnt lgkmcnt(0)" ::: "memory");
#pragma unroll
        for (int d = 0; d < 2; ++d)
#pragma unroll
            for (int r = 0; r < 16; ++r) st.o[d][r] *= wsf[crow(r, hi)];
        st.l_reg *= alpha; st.mrun = mn;
    }
    const float mref = st.mrun; float sacc = 0.f;
#pragma unroll
    for (int r = 0; r < 16; ++r) { p0[r] = __builtin_amdgcn_exp2f(p0[r] - mref); p1[r] = __builtin_amdgcn_exp2f(p1[r] - mref); sacc += p0[r] + p1[r]; }
    st.l_reg += sacc;
#define PKW(P, B) cvt_pk_bf16(P[B], P[B + 1])
    pw[0] = (v4u){PKW(p0, 0), PKW(p0, 2), PKW(p0, 4), PKW(p0, 6)}; pw[1] = (v4u){PKW(p0, 8), PKW(p0, 10), PKW(p0, 12), PKW(p0, 14)};
    pw[2] = (v4u){PKW(p1, 0), PKW(p1, 2), PKW(p1, 4), PKW(p1, 6)}; pw[3] = (v4u){PKW(p1, 8), PKW(p1, 10), PKW(p1, 12), PKW(p1, 14)};
#undef PKW
}
__device__ __forceinline__ void attn_pv(AttnState& st, const v4u (&pw)[4], lds_cptr vp) {
    pv(st.o, vp, __builtin_bit_cast(bf16x8, pw[0]), __builtin_bit_cast(bf16x8, pw[1]), __builtin_bit_cast(bf16x8, pw[2]), __builtin_bit_cast(bf16x8, pw[3]));
}
__device__ __forceinline__ void attn_store_o(AttnState& st, bf16* Ow, LAS float* wsf, LAS bf16* stg, int lane, int r32, int hi) {
    float l = st.l_reg;
    { auto rr = __builtin_amdgcn_permlane32_swap(__float_as_uint(l), __float_as_uint(l), false, false); l = __uint_as_float(rr[0]) + __uint_as_float(rr[1]); }
    if (hi == 0) wsf[32 + r32] = l;
    asm volatile("s_waitcnt lgkmcnt(0)" ::: "memory");
    float rli[16];
#pragma unroll
    for (int r = 0; r < 16; ++r) rli[r] = __builtin_amdgcn_rcpf(wsf[32 + crow(r, hi)]);
#pragma unroll
    for (int r = 0; r < 16; ++r) { const int orow = crow(r, hi);
#pragma unroll
        for (int d0 = 0; d0 < 2; ++d0) stg[orow * 64 + d0 * 32 + r32] = (bf16)(cvt_pk_bf16(st.o[d0][r] * rli[r], 0.f) & 0xffffu); }
    asm volatile("s_waitcnt lgkmcnt(0)" ::: "memory");
#pragma unroll
    for (int i = 0; i < 4; ++i) { const int row = i * 8 + (lane >> 3), ch = lane & 7; const v4u v = *(const LAS v4u*)(stg + row * 64 + ch * 8); *(v4u*)(Ow + (long)row * OP + ch * 8) = v; }
    asm volatile("s_waitcnt lgkmcnt(0)" ::: "memory");
}
template <int HALFB>
__device__ __forceinline__ void attn_pair_loop(int wid, int lane, int b, int h, int qbA, int qbB, const bf16* Q, const bf16* K, const bf16* V, bf16* O, char* shm) {
    const int r32 = lane & 31, hi = lane >> 5;
    const long rowbase = (long)b * SEQ;
    const bf16* Kh = K + rowbase * KP + h * DQK; const bf16* Vh = V + rowbase * VP + h * DVH;
    const unsigned lds0 = (unsigned)(uintptr_t)shm;
    const lds_cptr shm3 = (lds_cptr)shm;
    LAS float* wsf = (LAS float*)(shm3 + L2_WS) + wid * 64;
    LAS bf16* stg = (LAS bf16*)(shm3 + L2_OST) + wid * 2048;
    const bf16* ksrc0 = Kh + (long)lane * KP + wid * 8;
    const bf16* ksrc1 = Kh + (long)lane * KP + (8 + (wid & 3)) * 8;
    const bf16* vsrc = Vh + (long)(16 * (wid & 3) + (lane >> 2)) * VP + (wid >> 2) * 32 + (lane & 3) * 8;
    const unsigned kdst0 = lds0 + L2_K + wid * 1024, kdst1 = lds0 + L2_K + (8 + (wid & 3)) * 1024, vdst = lds0 + L2_V + wid * 1024;
#define DMA_KV(t, ks, vs) do { glds16(ksrc0 + (long)(t) * KVBLK * KP, (unsigned)__builtin_amdgcn_readfirstlane(kdst0 + (ks) * KSLOT)); \
        if (wid < 4) glds16(ksrc1 + (long)(t) * KVBLK * KP, (unsigned)__builtin_amdgcn_readfirstlane(kdst1 + (ks) * KSLOT)); \
        glds16(vsrc + (long)(t) * KVBLK * VP, (unsigned)__builtin_amdgcn_readfirstlane(vdst + (vs) * VSLOT)); } while (0)
    const lds_cptr vp0 = shm3 + L2_V + ((lane >> 4) & 1) * 32 + (lane & 3) * 8 + (4 * hi + ((lane & 15) >> 2)) * 64;
    const int q0A = qbA * QBR, q0B = qbB * QBR, NTa = (q0A + QBR) / KVBLK, NTb = (q0B + QBR) / KVBLK, G = NTa + NTb;
    const int qrel = wid * 32 + r32;
    const bf16* QwA = Q + (rowbase + q0A + wid * 32) * QP + h * DQK; const bf16* QwB = Q + (rowbase + q0B + wid * 32) * QP + h * DQK;
    bf16* OwA = O + (rowbase + q0A + wid * 32) * OP + 512 + h * DVH; bf16* OwB = O + (rowbase + q0B + wid * 32) * OP + 512 + h * DVH;
    DMA_KV(0, 0, 0);
    AttnState st; attn_load_q(st, QwA, r32, hi);
    v4u pw[4]; pw[0] = pw[1] = pw[2] = pw[3] = (v4u){0u, 0u, 0u, 0u};
    asm volatile("s_waitcnt vmcnt(0) lgkmcnt(0)\n\ts_barrier" ::: "memory");
    int vs = 0;
    for (int g = 0; g < G; ++g) {
        const int ks = g & 1, vsn = (vs == NSV - 1) ? 0 : vs + 1, vsp = (vs == 0) ? NSV - 1 : vs - 1;
        const bool inB = g >= NTa; const int t = inB ? g - NTa : g, NT = inB ? NTb : NTa;
        if (g + 1 < G) { const int tn = (g + 1 >= NTa) ? g + 1 - NTa : g + 1; DMA_KV(tn, ks ^ 1, vsn); }
        if (HALFB) {
            if (g > 0) { attn_pv(st, pw, vp0 + vsp * VSLOT);
                if (g == NTa) { attn_store_o(st, OwA, wsf, stg, lane, r32, hi); attn_load_q(st, QwB, r32, hi); } }
            attn_scores(st, pw, shm3 + L2_K + ks * KSLOT, t, NT, qrel, r32, hi, wsf);
        } else {
            attn_scores(st, pw, shm3 + L2_K + ks * KSLOT, t, NT, qrel, r32, hi, wsf);
            attn_pv(st, pw, vp0 + vs * VSLOT);
            if (g == NTa - 1) { attn_store_o(st, OwA, wsf, stg, lane, r32, hi); attn_load_q(st, QwB, r32, hi); }
        }
        asm volatile("s_waitcnt vmcnt(0) lgkmcnt(0)\n\ts_barrier" ::: "memory");
        vs = vsn;
    }
    if (HALFB) attn_pv(st, pw, vp0 + ((vs == 0) ? NSV - 1 : vs - 1) * VSLOT);
    attn_store_o(st, OwB, wsf, stg, lane, r32, hi);
    asm volatile("s_waitcnt vmcnt(0) lgkmcnt(0)\n\ts_barrier" ::: "memory");
#undef DMA_KV
}
__device__ __forceinline__ void attn_pair(int wave, int b, int h, int qbA, int qbB, const bf16* Q, const bf16* K, const bf16* V, bf16* O, char* shm) {
    const int lane = fresh_lane(); int wid_ = wave; asm volatile("" : "+s"(wid_));
    if (wid_ < 4) attn_pair_loop<0>(wid_, lane, b, h, qbA, qbB, Q, K, V, O, shm);
    else attn_pair_loop<1>(wid_, lane, b, h, qbA, qbB, Q, K, V, O, shm);
}
}

namespace att2 {
using att::f32x16; using att::s16x4; using att::lds_cptr; using att::crow; using att::glds16; using att::cmask; using att::vtr;
constexpr int QBR = 256, KVBLK = 64, QP = 768, KP = 768, VP = 512, OP = 1024;
constexpr int KSLOT = 12288, VSLOT = 8192, NKS = 4, NVS = 3;
constexpr int LDS_K = 0, LDS_V = NKS * KSLOT, LDS_WS = LDS_V + NVS * VSLOT, LDS_OST = LDS_WS + 8 * 256, LDS_BYTES = LDS_OST + 8 * 4096;
__device__ __forceinline__ void glds16s(unsigned voff, const void* sbase, unsigned lds_dst) { unsigned keep;
    asm volatile("s_mov_b32 %0, m0\n\ts_mov_b32 m0, %3\n\ts_nop 0\n\tglobal_load_lds_dwordx4 %1, %2\n\ts_mov_b32 m0, %0" : "=&s"(keep) : "v"(voff), "s"(sbase), "s"(lds_dst) : "memory"); }
#define SBAR() __builtin_amdgcn_sched_barrier(0)
#define WAIT_BAR(N) asm volatile("s_waitcnt vmcnt(" #N ") lgkmcnt(0)\n\ts_barrier" ::: "memory")
__device__ __forceinline__ float max3f(float a, float b, float c) { float r; asm("v_max3_f32 %0, %1, %2, %3" : "=v"(r) : "v"(a), "v"(b), "v"(c)); return r; }
__device__ __forceinline__ float max2f(float a, float b) { float r; asm("v_max_f32_e32 %0, %1, %2" : "=v"(r) : "v"(a), "v"(b)); return r; }
__device__ __forceinline__ float fadd_s(float a, float b) { float r; asm("v_add_f32_e32 %0, %1, %2" : "=v"(r) : "v"(a), "v"(b)); return r; }
__device__ __forceinline__ float fsub_s(float a, float b) { float r; asm("v_sub_f32_e32 %0, %1, %2" : "=v"(r) : "v"(a), "v"(b)); return r; }
__device__ __forceinline__ void qkt(f32x16& p0, f32x16& p1, lds_cptr kslot, const bf16x8* qr, const f32x16& negm, int r32, int hi) {
    lds_cptr kb = kslot + hi * 1024 + r32 * 16;
#pragma unroll
    for (int d0 = 0; d0 < 6; ++d0) {
        const bf16x8 b0 = *(const LAS bf16x8*)(kb + d0 * 2048);
        const bf16x8 b1 = *(const LAS bf16x8*)(kb + d0 * 2048 + 512);
        if (d0 == 0) { p0 = __builtin_amdgcn_mfma_f32_32x32x16_bf16(b0, qr[0], negm, 0, 0, 0); p1 = __builtin_amdgcn_mfma_f32_32x32x16_bf16(b1, qr[0], negm, 0, 0, 0); }
        else { p0 = __builtin_amdgcn_mfma_f32_32x32x16_bf16(b0, qr[d0], p0, 0, 0, 0); p1 = __builtin_amdgcn_mfma_f32_32x32x16_bf16(b1, qr[d0], p1, 0, 0, 0); } }
}
__device__ __forceinline__ void kload2(bf16x8* kf, lds_cptr kp, int j) { kf[2 * j] = *(const LAS bf16x8*)(kp + j * 2048); kf[2 * j + 1] = *(const LAS bf16x8*)(kp + j * 2048 + 512); }
__device__ __forceinline__ float rowmax(const f32x16& p0, const f32x16& p1) {
    float a = max3f(p0[0], p0[1], p1[0]), b = max3f(p0[2], p0[3], p1[1]); a = max3f(a, p1[2], p1[3]);
#pragma unroll
    for (int r = 4; r < 16; r += 4) { a = max3f(a, p0[r], p0[r + 1]); b = max3f(b, p0[r + 2], p0[r + 3]); a = max3f(a, p1[r], p1[r + 1]); b = max3f(b, p1[r + 2], p1[r + 3]); }
    const float m = max2f(a, b);
    auto rr = __builtin_amdgcn_permlane32_swap(__float_as_uint(m), __float_as_uint(m), false, false);
    return max2f(__uint_as_float(rr[0]), __uint_as_float(rr[1]));
}
__device__ __forceinline__ void pv(f32x16* o, int vb, bf16x8 pa0, bf16x8 pa1, bf16x8 pa2, bf16x8 pa3) {
#pragma unroll
    for (int d0 = 0; d0 < 2; ++d0) { s16x4 lo[4], hi[4];
#pragma unroll
        for (int ks = 0; ks < 4; ++ks) {
            asm volatile("ds_read_b64_tr_b16 %0,%1 offset:%c2" : "=&v"(lo[ks]) : "v"(vb), "i"(d0 * 4096 + ks * 1024) : "memory");
            asm volatile("ds_read_b64_tr_b16 %0,%1 offset:%c2" : "=&v"(hi[ks]) : "v"(vb), "i"(d0 * 4096 + ks * 1024 + 512) : "memory"); }
        asm volatile("s_waitcnt lgkmcnt(0)" ::: "memory"); SBAR();
#define PK(k) (bf16x8){lo[k][0], lo[k][1], lo[k][2], lo[k][3], hi[k][0], hi[k][1], hi[k][2], hi[k][3]}
        o[d0] = __builtin_amdgcn_mfma_f32_32x32x16_bf16(pa0, PK(0), o[d0], 0, 0, 0);
        o[d0] = __builtin_amdgcn_mfma_f32_32x32x16_bf16(pa1, PK(1), o[d0], 0, 0, 0);
        o[d0] = __builtin_amdgcn_mfma_f32_32x32x16_bf16(pa2, PK(2), o[d0], 0, 0, 0);
        o[d0] = __builtin_amdgcn_mfma_f32_32x32x16_bf16(pa3, PK(3), o[d0], 0, 0, 0);
#undef PK
    }
}
struct ConvItem { v4u cu[6], bg[4]; f32x4 wa[3], wb[3]; };
__device__ __forceinline__ void conv_issue(ConvItem& c, const bf16* CU, const bf16* ZB, const float* cw, long it) {
    const long row0 = (it >> 6) * 4; const int c8 = (int)(it & 63) * 8; const int sp0 = (int)(row0 & (SEQ - 1));
#pragma unroll
    for (int k = 0; k < 6; ++k) c.cu[k] = (sp0 - 2 + k >= 0) ? *(const v4u*)(CU + (row0 - 2 + k) * DCONV + c8) : (v4u){0u, 0u, 0u, 0u};
#pragma unroll
    for (int r = 0; r < 4; ++r) c.bg[r] = __builtin_nontemporal_load((const v4u*)(ZB + (row0 + r) * 1024 + c8));
#pragma unroll
    for (int k = 0; k < 3; ++k) { c.wa[k] = *(const f32x4*)(cw + k * DCONV + c8); c.wb[k] = *(const f32x4*)(cw + k * DCONV + c8 + 4); }
}
__device__ __forceinline__ void conv_finish(const ConvItem& c, bf16* ZB, long it) {
    const long row0 = (it >> 6) * 4; const int c8 = (int)(it & 63) * 8;
    f32x4 ca[6], cb[6];
#pragma unroll
    for (int k = 0; k < 6; ++k) unpack8(c.cu[k], ca[k], cb[k]);
#pragma unroll
    for (int r = 0; r < 4; ++r) { const f32x4 accA = ca[r] * c.wa[0] + ca[r + 1] * c.wa[1] + ca[r + 2] * c.wa[2], accB = cb[r] * c.wb[0] + cb[r + 1] * c.wb[1] + cb[r + 2] * c.wb[2];
        f32x4 ba, bb; unpack8(c.bg[r], ba, bb); pg8::st16(ZB, (size_t)((row0 + r) * 1024 + c8), pack8(ba * accA, bb * accB)); }
}
template <int THRL> __device__ __forceinline__ void attn_unit(int wave, int b, int h, int qb, const bf16* Q, const bf16* __restrict__ K, const bf16* __restrict__ V, bf16* O, char* shm, const bf16* CU, const float* cw, long itb) {
    const int lane = fresh_lane(); int wid_ = wave; asm volatile("" : "+s"(wid_));
    const int r32 = lane & 31, hi = lane >> 5, wid = wid_;
    const long rowbase = (long)b * SEQ; const int q0 = qb * QBR;
    const bf16* Qw = Q + (rowbase + q0 + wid * 32) * QP + h * DQK;
    const bf16* Kh = K + rowbase * KP + h * DQK; const bf16* Vh = V + rowbase * VP + h * DVH;
    const unsigned lds0 = (unsigned)(uintptr_t)shm;
    float* wsf = (float*)(shm + LDS_WS) + wid * 64;
    if (wid >= 4) __builtin_amdgcn_s_setprio(1);
    const unsigned koff0 = (unsigned)(lane * KP + wid * 8) * 2u, koff1 = (unsigned)(lane * KP + (8 + (wid & 3)) * 8) * 2u;
    const unsigned voffv = (unsigned)((16 * (wid & 3) + (lane >> 2)) * VP + (wid >> 2) * 32 + (lane & 3) * 8) * 2u;
    const unsigned kdst0 = lds0 + LDS_K + wid * 1024, kdst1 = lds0 + LDS_K + (8 + (wid & 3)) * 1024, vdst = lds0 + LDS_V + wid * 1024;
#define DMA_K(t, slot) do { const bf16* kb_ = Kh + (long)(t) * KVBLK * KP; glds16s(koff0, kb_, (unsigned)__builtin_amdgcn_readfirstlane(kdst0 + (slot))); glds16s(koff1, kb_, (unsigned)__builtin_amdgcn_readfirstlane(kdst1 + (slot))); } while (0)
#define DMA_V(t, slot) glds16s(voffv, Vh + (long)(t) * KVBLK * VP, (unsigned)__builtin_amdgcn_readfirstlane(vdst + (slot)))
    const int vb0 = (int)(lds0 + LDS_V) + ((lane >> 4) & 1) * 32 + (lane & 3) * 8 + (4 * hi + ((lane & 15) >> 2)) * 64;
    const lds_cptr shm3 = (lds_cptr)shm; const lds_cptr kp0 = shm3 + LDS_K + hi * 1024 + r32 * 16; const lds_cptr vp0 = shm3 + LDS_V + ((lane >> 4) & 1) * 32 + (lane & 3) * 8 + (4 * hi + ((lane & 15) >> 2)) * 64;
    bf16x8 kf[8];
    const int NT = (q0 + QBR) / KVBLK;
    DMA_K(0, 0); DMA_V(0, 0); DMA_K(1, KSLOT);
    bf16x8 qr[6];
#pragma unroll
    for (int d0 = 0; d0 < 6; ++d0) qr[d0] = *reinterpret_cast<const bf16x8*>(&Qw[(long)r32 * QP + d0 * 16 + hi * 8]);
    float mhat = 0.f, l_reg = 0.f; f32x16 o[2]; o[0] = f32x16{}; o[1] = f32x16{}; f32x16 negm; { float z_ = 0.f; asm volatile("" : "+v"(z_)); _Pragma("unroll") for (int r = 0; r < 16; ++r) negm[r] = z_; }
    const int qrel = wid * 32 + r32;
#define CMASK(P0, P1, t) do { int jb_ = (t) - (NT - 4); if (jb_ >= 0) cmask(P0, P1, jb_, qrel, hi); } while (0)
    bool resc = false;
#define START(P0, P1) do { const float rm = rowmax(P0, P1); resc = false; \
    { const float dl = rm; mhat = fadd_s(mhat, dl); \
      _Pragma("unroll") for (int r = 0; r < 16; ++r) { P0[r] = fsub_s(P0[r], dl); P1[r] = fsub_s(P1[r], dl); } \
      _Pragma("unroll") for (int r = 0; r < 16; ++r) negm[r] = -mhat; asm volatile("" : "+v"(negm)); } \
    _Pragma("unroll") for (int r = 0; r < 16; ++r) P0[r] = __builtin_amdgcn_exp2f(P0[r]); } while (0)
#define RESC() do { if (resc) { asm volatile("s_waitcnt lgkmcnt(0)" ::: "memory"); \
      _Pragma("unroll") for (int d_ = 0; d_ < 2; ++d_) _Pragma("unroll") for (int r = 0; r < 16; ++r) o[d_][r] *= wsf[crow(r, hi)]; } } while (0)
    f32x16 pA0, pA1, pB0, pB1;
    int kprev = 3 * KSLOT, kcur = 0, knext = KSLOT;
    int vprev = 0, vcur = 0, vnext = VSLOT;
#define ROT() do { kprev = kcur; kcur = knext; knext = (knext == (NKS - 1) * KSLOT) ? 0 : knext + KSLOT; vprev = vcur; vcur = vnext; vnext = (vnext == (NVS - 1) * VSLOT) ? 0 : vnext + VSLOT; } while (0)
    DMA_K(2, 2 * KSLOT);
    WAIT_BAR(5);
    qkt(pA0, pA1, shm3 + LDS_K, qr, negm, r32, hi); asm volatile("s_nop 15\n\ts_nop 7" : "+v"(pA0), "+v"(pA1)); CMASK(pA0, pA1, 0);
    START(pA0, pA1);
    _Pragma("unroll") for (int r = 0; r < 16; ++r) pA1[r] = __builtin_amdgcn_exp2f(pA1[r]);
    WAIT_BAR(0);
    DMA_K(3, 3 * KSLOT); DMA_V(1, VSLOT);
    ROT();
#pragma unroll
    for (int j = 0; j < 4; ++j) kload2(kf, kp0 + kcur, j);
    WAIT_BAR(3);
    s16x4 vlo[8], vhi[8]; v4u pw0, pw1, pw2, pw3; bf16x8 kx0, kx1, kx2, kx3;
#define PKW(P, B) cvt_pk_bf16(P[B], P[B + 1])
#define PAF(k) __builtin_bit_cast(bf16x8, pw##k)
#define VFR(i) (bf16x8){vlo[i][0], vlo[i][1], vlo[i][2], vlo[i][3], vhi[i][0], vhi[i][1], vhi[i][2], vhi[i][3]}
#define PIN(x) asm volatile("" : "+v"(x))
#define MX3(a, b, c) __builtin_fmaxf(__builtin_fmaxf((a), (b)), (c))
#define MFQ(c, k, q, cin) c = __builtin_amdgcn_mfma_f32_32x32x16_bf16(kf[k], qr[q], cin, 0, 0, 0)
#define MFX(c, kx, q, cin) c = __builtin_amdgcn_mfma_f32_32x32x16_bf16(kx, qr[q], cin, 0, 0, 0)
#define GAPA(MF, A0, A1, A2, A3, W0, W1, PW) do { MF; sacc += A0; sacc += A1; sacc += A2; sacc += A3; PIN(sacc); W0; W1; PIN(PW); SBAR(); } while (0)
#define GAPN(MF) do { MF; SBAR(); } while (0)
#define EX(v) __builtin_amdgcn_exp2f(v)
#define GAPB(MF, X, B) do { MF; X[B] = EX(X[B]); X[B + 1] = EX(X[B + 1]); X[B + 2] = EX(X[B + 2]); X[B + 3] = EX(X[B + 3]); PIN(X); SBAR(); } while (0)
#define VRD(i) do { vlo[i] = vtr(vp_ + (((i) >> 2) * 4096 + ((i) & 3) * 1024)); vhi[i] = vtr(vp_ + (((i) >> 2) * 4096 + ((i) & 3) * 1024 + 512)); } while (0)
#define KRD(G, j) do { if (G) { kload2(kf, kp0 + knext, j); SBAR(); } } while (0)
#define STEP(C0, C1, P0, P1, t, GK, GV, GL) do { SBAR(); \
    const lds_cptr vp_ = vp0 + vprev; \
    VRD(0); SBAR(); float sacc = (P0[0] + P0[1]); \
    GAPA(MFQ(C0, 0, 0, negm), P0[2], P0[3], P0[4], P0[5],     pw0[0] = PKW(P0, 0), pw0[1] = PKW(P0, 2), pw0); \
    VRD(4); SBAR(); GAPA(MFQ(C1, 1, 0, negm), P0[6], P0[7], P0[8], P0[9],     pw0[2] = PKW(P0, 4), pw0[3] = PKW(P0, 6), pw0); \
    VRD(1); SBAR(); GAPA(MFQ(C0, 2, 1, C0),   P0[10], P0[11], P0[12], P0[13], pw1[0] = PKW(P0, 8), pw1[1] = PKW(P0, 10), pw1); \
    VRD(5); SBAR(); GAPA(MFQ(C1, 3, 1, C1),   P0[14], P0[15], P1[0], P1[1],   pw1[2] = PKW(P0, 12), pw1[3] = PKW(P0, 14), pw1); \
    VRD(2); SBAR(); GAPA(MFQ(C0, 4, 2, C0),   P1[2], P1[3], P1[4], P1[5],     pw2[0] = PKW(P1, 0), pw2[1] = PKW(P1, 2), pw2); \
    VRD(6); SBAR(); GAPA(MFQ(C1, 5, 2, C1),   P1[6], P1[7], P1[8], P1[9],     pw2[2] = PKW(P1, 4), pw2[3] = PKW(P1, 6), pw2); \
    VRD(3); kx0 = *(const LAS bf16x8*)(kp0 + kcur + 8192); kx1 = *(const LAS bf16x8*)(kp0 + kcur + 8192 + 512); SBAR(); GAPA(MFQ(C0, 6, 3, C0),   P1[10], P1[11], P1[12], P1[13], pw3[0] = PKW(P1, 8), pw3[1] = PKW(P1, 10), pw3); \
    VRD(7); kx2 = *(const LAS bf16x8*)(kp0 + kcur + 10240); kx3 = *(const LAS bf16x8*)(kp0 + kcur + 10240 + 512); SBAR(); GAPA(MFQ(C1, 7, 3, C1),   P1[14], P1[15], 0.f, 0.f,       pw3[2] = PKW(P1, 12), pw3[3] = PKW(P1, 14), pw3); \
    GAPN(MFX(C0, kx0, 4, C0)); GAPN(MFX(C1, kx1, 4, C1)); GAPN(MFX(C0, kx2, 5, C0)); GAPN(MFX(C1, kx3, 5, C1)); \
    l_reg += sacc; \
    if (GK) { DMA_K((t) + 3, kprev); } if (GV) { DMA_V((t) + 1, vnext); } \
    CMASK(C0, C1, t); \
    { float a = MX3(C0[0], C0[1], C1[0]), b = MX3(C0[2], C0[3], C1[1]); a = MX3(a, C1[2], C1[3]); \
      _Pragma("unroll") for (int r = 4; r < 16; r += 4) { a = MX3(a, C0[r], C0[r + 1]); b = MX3(b, C0[r + 2], C0[r + 3]); a = MX3(a, C1[r], C1[r + 1]); b = MX3(b, C1[r + 2], C1[r + 3]); } \
      float rm = __builtin_fmaxf(a, b); { auto rr = __builtin_amdgcn_permlane32_swap(__float_as_uint(rm), __float_as_uint(rm), false, false); rm = __builtin_fmaxf(__uint_as_float(rr[0]), __uint_as_float(rr[1])); } \
      resc = false; \
      if (__builtin_expect(__any(rm > (float)THRL), 0)) { const float dl = __builtin_fmaxf(rm, 0.f); mhat += dl; \
        _Pragma("unroll") for (int r = 0; r < 16; ++r) { C0[r] -= dl; C1[r] -= dl; } \
        _Pragma("unroll") for (int r = 0; r < 16; ++r) negm[r] = -mhat; asm volatile("" : "+v"(negm)); \
        const float f = __builtin_amdgcn_exp2f(-dl); l_reg *= f; if (hi == 0) wsf[r32] = f; resc = true; } } \
    SBAR(); \
    GAPB(o[0] = __builtin_amdgcn_mfma_f32_32x32x16_bf16(PAF(0), VFR(0), o[0], 0, 0, 0), C0, 0); \
    GAPB(o[1] = __builtin_amdgcn_mfma_f32_32x32x16_bf16(PAF(0), VFR(4), o[1], 0, 0, 0), C0, 4); \
    KRD(GL, 0); GAPB(o[0] = __builtin_amdgcn_mfma_f32_32x32x16_bf16(PAF(1), VFR(1), o[0], 0, 0, 0), C0, 8); \
    KRD(GL, 1); GAPB(o[1] = __builtin_amdgcn_mfma_f32_32x32x16_bf16(PAF(1), VFR(5), o[1], 0, 0, 0), C0, 12); \
    KRD(GL, 2); GAPB(o[0] = __builtin_amdgcn_mfma_f32_32x32x16_bf16(PAF(2), VFR(2), o[0], 0, 0, 0), C1, 0); \
    KRD(GL, 3); GAPB(o[1] = __builtin_amdgcn_mfma_f32_32x32x16_bf16(PAF(2), VFR(6), o[1], 0, 0, 0), C1, 4); \
    GAPB(o[0] = __builtin_amdgcn_mfma_f32_32x32x16_bf16(PAF(3), VFR(3), o[0], 0, 0, 0), C1, 8); \
    GAPB(o[1] = __builtin_amdgcn_mfma_f32_32x32x16_bf16(PAF(3), VFR(7), o[1], 0, 0, 0), C1, 12); \
    } while (0)
    int t = 1;
#undef CMASK
#define CMASK(P0, P1, t) do { } while (0)
    for (; t + 5 < NT; t += 2) {
        STEP(pB0, pB1, pA0, pA1, t, true, true, true);     WAIT_BAR(3); RESC(); ROT();
        STEP(pA0, pA1, pB0, pB1, t + 1, true, true, true); WAIT_BAR(3); RESC(); ROT();
    }
#undef CMASK
#define CMASK(P0, P1, t) do { int jb_ = (t) - (NT - 4); if (jb_ >= 0) cmask(P0, P1, jb_, qrel, hi); } while (0)
#define ENDW(tt) do { if ((tt) + 3 < NT) { WAIT_BAR(3); } else if ((tt) + 2 < NT) { WAIT_BAR(1); } else { WAIT_BAR(0); } } while (0)
    for (; t + 1 < NT; t += 2) {
        STEP(pB0, pB1, pA0, pA1, t, (t + 3 < NT), (t + 1 < NT), (t + 1 < NT));         ENDW(t);     RESC(); ROT();
        STEP(pA0, pA1, pB0, pB1, t + 1, (t + 4 < NT), (t + 2 < NT), (t + 2 < NT));     ENDW(t + 1); RESC(); ROT();
    }
    STEP(pB0, pB1, pA0, pA1, NT - 1, false, false, false); RESC();
    { float sacc = pB0[0] + pB0[1]; _Pragma("unroll") for (int r = 2; r < 16; ++r) sacc += pB0[r]; _Pragma("unroll") for (int r = 0; r < 16; ++r) sacc += pB1[r]; l_reg += sacc;
      pw0 = (v4u){PKW(pB0, 0), PKW(pB0, 2), PKW(pB0, 4), PKW(pB0, 6)}; pw1 = (v4u){PKW(pB0, 8), PKW(pB0, 10), PKW(pB0, 12), PKW(pB0, 14)}; pw2 = (v4u){PKW(pB1, 0), PKW(pB1, 2), PKW(pB1, 4), PKW(pB1, 6)}; pw3 = (v4u){PKW(pB1, 8), PKW(pB1, 10), PKW(pB1, 12), PKW(pB1, 14)};
      SBAR(); pv(o, vb0 + vcur, PAF(0), PAF(1), PAF(2), PAF(3)); }
#undef PKW
#undef PAF
#undef VFR
#undef PIN
#undef MX3
#undef MFQ
#undef MFX
#undef GAPA
#undef GAPN
#undef GAPB
#undef EX
#undef VRD
#undef KRD
#undef STEP
#undef ENDW
    ConvItem cv; const long cit = itb + wid * 64 + fresh_lane(); conv_issue(cv, CU, O, cw, cit);
    { auto rr = __builtin_amdgcn_permlane32_swap(__float_as_uint(l_reg), __float_as_uint(l_reg), false, false); l_reg = __uint_as_float(rr[0]) + __uint_as_float(rr[1]); }
    if (hi == 0) wsf[32 + r32] = l_reg; asm volatile("s_waitcnt lgkmcnt(0)" ::: "memory");
    float rli[16];
#pragma unroll
    for (int r = 0; r < 16; ++r) rli[r] = __builtin_amdgcn_rcpf(wsf[32 + crow(r, hi)]);
    bf16* Ow = O + (rowbase + q0 + wid * 32) * OP + 512 + h * DVH;
    { bf16* stg = (bf16*)(shm + LDS_OST) + wid * 2048;
#pragma unroll
      for (int r = 0; r < 16; ++r) { const int orow = crow(r, hi);
#pragma unroll
        for (int d0 = 0; d0 < 2; ++d0) stg[orow * 64 + d0 * 32 + r32] = (bf16)(cvt_pk_bf16(o[d0][r] * rli[r], 0.f) & 0xffffu); }
      asm volatile("s_waitcnt lgkmcnt(0)" ::: "memory");
#pragma unroll
      for (int i = 0; i < 4; ++i) { const int row = i * 8 + (lane >> 3), ch = lane & 7; const v4u v = *(const v4u*)(stg + row * 64 + ch * 8); pg8::st16(Ow, (size_t)(row * OP + ch * 8), v); } }
    conv_finish(cv, O, cit);
    asm volatile("s_waitcnt lgkmcnt(0)\n\ts_barrier" ::: "memory");
    __builtin_amdgcn_s_setprio(0);
#undef DMA_K
#undef DMA_V
#undef CMASK
#undef START
#undef RESC
#undef ROT
}
#undef SBAR
#undef WAIT_BAR
}

constexpr int NWAVES = 8, GRID = 256;
constexpr int RING_OFF = 0, RING_BYTES = 131072;
constexpr int LDSCTL_OFF = RING_BYTES, MISC_OFF = LDSCTL_OFF + 320, RS_OFF = RING_BYTES + 1024;
constexpr int MOETAB_OFF = RS_OFF + 2048;
constexpr int LDS_BYTES = 147456;
static_assert(att::L2_BYTES <= RING_BYTES && att2::LDS_BYTES <= RING_BYTES && RS_OFF + 2048 <= LDS_BYTES, "lds map");

#define RLX_AGENT __ATOMIC_RELAXED, __HIP_MEMORY_SCOPE_AGENT
#define LDS_WAIT() asm volatile("s_waitcnt lgkmcnt(0)" ::: "memory")
#define VM_WAIT() asm volatile("s_waitcnt vmcnt(0)" ::: "memory")

#define XB_TMO      128
#define XB_XCNT(j)  (256  + 64 * (j))
#define XB_XSUB(j)  (1280 + 64 * (j))
#define XB_XGEN(j)  (2304 + 64 * (j))
#define XB_TOP      3328
#define XB_TOPGEN   3392
#define XCD_BAR_WORDS 3456
#define XB_SPIN_CAP (1u << 18)
__device__ __forceinline__ unsigned xb_ld(unsigned* p)              { return __hip_atomic_load(p, __ATOMIC_RELAXED, __HIP_MEMORY_SCOPE_AGENT); }
__device__ __forceinline__ unsigned xb_add(unsigned* p, unsigned v) { return __hip_atomic_fetch_add(p, v, __ATOMIC_RELAXED, __HIP_MEMORY_SCOPE_AGENT); }
__device__ __forceinline__ unsigned xb_xcc_id() { return (unsigned)__builtin_amdgcn_s_getreg((3 << 11) | 20) & 0xFu; }
#define XB_SPIN(cond, bar) do { unsigned _sp = 0; while (cond) { __builtin_amdgcn_s_sleep(1); \
    if ((++_sp & 255u) == 0u) { if (xb_ld(&(bar)[XB_TMO])) break; if (_sp > XB_SPIN_CAP) { atomicAdd(&(bar)[XB_TMO], 1u); break; } } } } while (0)
struct XcdBarrier { unsigned* bar; unsigned x; volatile LAS unsigned* st; };
__device__ __forceinline__ XcdBarrier xcd_barrier_post(unsigned* bar, volatile LAS unsigned* st) {
    XcdBarrier b; b.bar = bar; b.x = (unsigned)__builtin_amdgcn_readfirstlane((int)xb_xcc_id()); b.st = st;
    if (threadIdx.x == 0) (void)xb_add(&bar[XB_XCNT(b.x)], 1u);
    return b;
}
__device__ __forceinline__ void xcd_barrier_complete(unsigned* bar, unsigned x, unsigned& nloc, unsigned& nx) {
    const unsigned G = (unsigned)GRID;
    unsigned sum, cnt, mine, sp = 0u;
    for (;;) {
        sum = 0u; cnt = 0u; mine = 0u;
#pragma unroll
        for (unsigned j = 0; j < 16; ++j) { const unsigned c = xb_ld(&bar[XB_XCNT(j)]); sum += c; cnt += (c > 0u) ? 1u : 0u; mine = (j == x) ? c : mine; }
        if (sum == G) break;
        __builtin_amdgcn_s_sleep(1);
        if ((++sp & 255u) == 0u) { if (xb_ld(&bar[XB_TMO])) break; if (sp > XB_SPIN_CAP) { atomicAdd(&bar[XB_TMO], 1u); break; } }
    }
    nloc = mine > 0u ? mine : 1u; nx = cnt > 0u ? cnt : 1u;
}
template <bool REL = true> __device__ __forceinline__ void xcd_barrier(const XcdBarrier& b) {
    asm volatile("s_waitcnt vmcnt(0)" ::: "memory");
    __syncthreads();
    if (threadIdx.x == 0) {
        unsigned* bar = b.bar;
        __builtin_amdgcn_s_waitcnt(0);
        unsigned nloc = b.st[0], nx = b.st[1];
        if (nloc == 0u) { xcd_barrier_complete(bar, b.x, nloc, nx); b.st[0] = nloc; b.st[1] = nx; }
        const unsigned old = xb_add(&bar[XB_XSUB(b.x)], 1u);
        const unsigned gen = old / nloc;
        if (old + 1u == (gen + 1u) * nloc) {
            if constexpr (REL) { __builtin_amdgcn_fence(__ATOMIC_RELEASE, "agent");
            asm volatile("s_waitcnt vmcnt(0)" ::: "memory"); }
            const unsigned og = xb_add(&bar[XB_TOP], 1u);
            const unsigned tg = og / nx;
            if (og + 1u == (tg + 1u) * nx) xb_add(&bar[XB_TOPGEN], 1u);
            else XB_SPIN(xb_ld(&bar[XB_TOPGEN]) == tg, bar);
            xb_add(&bar[XB_XGEN(b.x)], 1u);
            __builtin_amdgcn_fence(__ATOMIC_ACQUIRE, "agent");
            asm volatile("s_waitcnt vmcnt(0)" ::: "memory");
        } else {
            XB_SPIN(xb_ld(&bar[XB_XGEN(b.x)]) == gen, bar);
            __builtin_amdgcn_fence(__ATOMIC_ACQUIRE, "agent");
            asm volatile("s_waitcnt vmcnt(0)" ::: "memory");
        }
    }
    __syncthreads();
}

struct Args {
    const float *x; const int* pos; const float *attn_norm, *w_in, *conv_w, *w_conv_out, *q_norm, *w_uq, *kv_norm, *w_ukv, *w_mla_out, *w_o, *ffn_norm,
                *w_gate, *w_up, *w_down, *router, *w_gate_e, *w_up_e, *w_down_e, *final_norm;
    float* out; unsigned char* ws;
};
struct Frame { LAS unsigned char* lds; int tid, lane, wave, vcu; };
#define FRESH_LANE(F) do { const int l_ = fresh_lane(); (F).lane = l_; (F).tid = (F).wave * 64 + l_; } while (0)
typedef const __attribute__((address_space(4))) struct Args* kargs_t;
#define FRESH_ARGS() ({ kargs_t p_ = (kargs_t)__builtin_amdgcn_kernarg_segment_ptr(); asm volatile("" : "+s"(p_)); p_; })

__device__ __forceinline__ float wave_sum(float v) {
    v += swz_xor<1>(v); v += swz_xor<2>(v); v += swz_xor<4>(v); v += swz_xor<8>(v); v += swz_xor<16>(v);
    return xadd32(v);
}
__device__ __forceinline__ unsigned f2bf(float f) { unsigned u = __builtin_bit_cast(unsigned, f); return (u + 0x7fffu + ((u >> 16) & 1u)) >> 16; }
__device__ __forceinline__ unsigned pk2(float lo, float hi) { return f2bf(lo) | (f2bf(hi) << 16); }

enum { MAP_NAT = 0, MAP_WIN = 1, MAP_WUQ = 2, MAP_GU = 3 };
__device__ __forceinline__ int rope_pos_to_idx(int p) { return 16 * ((p & 7) >> 2) + 4 * (p >> 3) + (p & 3); }
__device__ __forceinline__ int map_src(int map, int d, int& which) {
    which = 0;
    if (map == MAP_NAT) return d;
    if (map == MAP_WUQ) { const int h = d / 96, w = d % 96; return w < 64 ? d : h * 96 + 64 + rope_pos_to_idx(w - 64); }
    if (map == MAP_GU) { const int t = d >> 8, r = d & 255; which = r >> 7; return t * 128 + (r & 127); }
    const int pn = d >> 8, r = d & 255;
    if (pn < 4) return (r < 128 ? 512 : 1024) + pn * 128 + (r & 127);
    if (pn < 6) return d - 1024;
    if (pn == 6) return 1536 + r;
    if (pn == 7) { if (r < 128) return 1792 + r; if (r < 160) return 2176 + rope_pos_to_idx(r - 128); return -1; }
    if (pn == 8) return 1920 + r;
    const int t = pn - 9; return (r < 128 ? 2208 : 3232) + t * 128 + (r & 127);
}
__device__ __forceinline__ void conv_item(const float* W, int ldk, int Nsrc, bf16* WT, int d0, int k0, int sc, const float* gain, LAS float* scr, int lane) {
    float v[32];
#pragma unroll
    for (int i = 0; i < 32; ++i) { const int kk = 2 * i + (lane >> 5); v[i] = sc >= 0 ? __builtin_nontemporal_load(W + (size_t)(k0 + kk) * Nsrc + sc) : 0.f; }
    if (gain) {
#pragma unroll
        for (int i = 0; i < 32; ++i) v[i] *= gain[k0 + 2 * i + (lane >> 5)]; }
#pragma unroll
    for (int i = 0; i < 32; ++i) scr[(2 * i + (lane >> 5)) * 33 + (lane & 31)] = v[i];
    LDS_WAIT(); asm volatile("" ::: "memory");
    const int c = lane & 7;
#pragma unroll
    for (int j = 0; j < 4; ++j) { const int n = (lane >> 3) + 8 * j; const LAS float* s = scr + (8 * c) * 33 + n;
        v4u o; o.x = pk2(s[0 * 33], s[1 * 33]); o.y = pk2(s[2 * 33], s[3 * 33]); o.z = pk2(s[4 * 33], s[5 * 33]); o.w = pk2(s[6 * 33], s[7 * 33]);
        pg8::st16(WT, (size_t)(d0 + n) * ldk + k0 + 8 * c, o); }
    LDS_WAIT(); asm volatile("" ::: "memory");
}
__device__ __forceinline__ long conv_matrix(Frame& F, long base, const float* W, const float* W2, int K, int Nsrc, int Ndest, bf16* WT, const float* gain, int map, int ldk = 0, int wg = -1, int nwg = GRID) {
    LAS float* scr = (LAS float*)(F.lds + RING_OFF + F.wave * 16384);
    const long gw = (long)(wg < 0 ? F.vcu : wg) * NWAVES + F.wave, NGW = (long)nwg * NWAVES;
    const int nb = Ndest / 32; const long n = (long)(K / 64) * nb; if (ldk == 0) ldk = K;
    long g = gw + ((base - gw + NGW - 1) / NGW) * NGW; if (g < base) g += NGW;
    for (; g < base + n; g += NGW) { const int it = (int)(g - base), kb = it / nb, db = it % nb; int which; const int sc = map_src(map, db * 32 + (F.lane & 31), which);
        const int w0 = __builtin_amdgcn_readfirstlane(which);
        conv_item(w0 ? W2 : W, ldk, Nsrc, WT, db * 32, kb * 64, sc, gain, scr, F.lane); }
    return base + n;
}


#ifndef LATE_CONV
#define LATE_CONV 2
#endif
#ifndef STOP_AFTER
#define STOP_AFTER 0
#endif
__device__ __forceinline__ void dump_fold(float* out, const bf16* b0, int ld0, int w0, const bf16* b1, int ld1, int w1, const bf16* b2, int ld2, int w2, const bf16* b3, int ld3, int w3, int bid, int tid) {
    for (long i = (long)bid * 512 + tid; i < (long)M * 1024; i += (long)GRID * 512) { const long r = i >> 10; const int c = (int)(i & 1023); float v = 0.f;
        if (b0) v += bflo(b0[r * ld0 + (c % w0)]); if (b1) v += 2.f * bflo(b1[r * ld1 + (c % w1)]); if (b2) v += 3.f * bflo(b2[r * ld2 + (c % w2)]); if (b3) v += 5.f * bflo(b3[r * ld3 + (c % w3)]);
        out[i] = v; }
}
__global__ void __launch_bounds__(NWAVES * 64, 2) trunk_fwd(Args a_unused) {
    extern __shared__ __attribute__((aligned(16))) unsigned char lds[];
    Frame F;
    F.lds = (LAS unsigned char*)lds;
    volatile LAS unsigned* MISC = (volatile LAS unsigned*)(F.lds + MISC_OFF);
    F.tid = threadIdx.x; F.lane = F.tid & 63; { int w_ = __builtin_amdgcn_readfirstlane(F.tid >> 6); asm volatile("" : "+s"(w_)); F.wave = w_; }
    { const int bx = blockIdx.x; F.vcu = (bx % 8) * (GRID / 8) + bx / 8; }
    for (int u = F.tid; u < (LDS_BYTES - LDSCTL_OFF) / 4; u += NWAVES * 64) ((LAS unsigned*)(F.lds + LDSCTL_OFF))[u] = 0u;
    __syncthreads();
    XcdBarrier bar = xcd_barrier_post((unsigned*)(FRESH_ARGS()->ws + WS_CTL) + CW_BAR, MISC + 8);
#define GRID_BAR() do { GRID_BAR1(); if (DUPB > 1) GRID_BAR1(); } while (0)
#define GRID_BAR1() do { XcdBarrier b2_; b2_.x = bar.x; asm volatile("" : "+s"(b2_.x)); b2_.st = MISC + 8; b2_.bar = (unsigned*)(FRESH_ARGS()->ws + WS_CTL) + CW_BAR; xcd_barrier<true>(b2_); } while (0)
#ifdef NO_LIGHT_BAR
#define GRID_BAR_WT() GRID_BAR()
#else
#define GRID_BAR_WT() do { XcdBarrier b2_; b2_.x = bar.x; asm volatile("" : "+s"(b2_.x)); b2_.st = MISC + 8; b2_.bar = (unsigned*)(FRESH_ARGS()->ws + WS_CTL) + CW_BAR; xcd_barrier<false>(b2_); } while (0)
#endif
#define WSP(T, off) ((T*)(ws + (off)))
#define MOE_TABLE() do { if (F.wave == 0) { LAS int* tab_ = (LAS int*)(F.lds + MOETAB_OFF); const unsigned* cnt_ = (const unsigned*)(ws + WS_CTL) + CW_CNT; int n8_ = 0, t_ = 0; \
        if (F.lane < NE) n8_ = (int)__hip_atomic_load(cnt_ + F.lane, RLX_AGENT); \
        _Pragma("unroll") for (int e_ = 0; e_ < NE; ++e_) { const int n_ = __builtin_amdgcn_readlane(n8_, e_); if (F.lane == 0) { tab_[e_] = t_; tab_[NE + 1 + e_] = n_; } t_ += (n_ + 255) / 256; } \
        if (F.lane == 0) tab_[NE] = t_; } \
        LDS_WAIT(); __syncthreads(); } while (0)
#ifdef NO_EARLY_DOWN
#define MOE_NEARLY() 0
#else
#define MOE_NEARLY() ({ int n_ = 4 * __builtin_amdgcn_readfirstlane(((const LAS int*)(F.lds + MOETAB_OFF))[NE]) - 2 * GRID; n_ < 0 ? 0 : (n_ > 32 ? 32 : n_); })
#endif
#define PHASE_BEGIN() FRESH_LANE(F); int bid = blockIdx.x; asm volatile("" : "+s"(bid)); (void)bid; kargs_t ka = FRESH_ARGS(); unsigned char* const ws = ka->ws; LAS float* const rsb = (LAS float*)(F.lds + RS_OFF); \
        const long gw = (long)F.vcu * NWAVES + F.wave, NGW = (long)GRID * NWAVES; (void)gw; (void)NGW; (void)rsb; (void)ws

#ifndef SKIP_P0
    for (int rep0_ = 0; rep0_ < DUP0; ++rep0_) {
        PHASE_BEGIN();
        bf16* WB = WSP(bf16, WS_W);
        const int rpos0 = ka->pos[(bid * 512 + F.tid) >> 4], rpos1 = ka->pos[(bid * 512 + F.tid + GRID * 512) >> 4];
        long base = 0;
#pragma unroll 1
        for (int l = 0; l < (LATE_CONV ? 1 : 2); ++l) {
            base = conv_matrix(F, base, ka->w_in + (size_t)l * DM * DIN, nullptr, DM, DIN, DINP, WB + WO_IN + l * W_IN_EL, ka->attn_norm + l * DM, MAP_WIN);
            base = conv_matrix(F, base, ka->w_uq + (size_t)l * QLORA * 768, nullptr, QLORA, 768, 768, WB + WO_UQ + l * W_UQ_EL, ka->q_norm + l * QLORA, MAP_WUQ);
            base = conv_matrix(F, base, ka->w_ukv + (size_t)l * KVLORA * 1024, nullptr, KVLORA, 1024, 1024, WB + WO_UKV + l * W_UKV_EL, ka->kv_norm + l * KVLORA, MAP_NAT);
            base = conv_matrix(F, base, ka->w_conv_out + (size_t)l * DCONV * DM, nullptr, DCONV, DM, DM, WB + WO_C + l * 2 * W_CM_EL, nullptr, MAP_NAT, 1024);
            base = conv_matrix(F, base, ka->w_mla_out + (size_t)l * 512 * DM, nullptr, 512, DM, DM, WB + WO_C + l * 2 * W_CM_EL + 512, nullptr, MAP_NAT, 1024);
            base = conv_matrix(F, base, ka->w_o + (size_t)l * DM * DM, nullptr, DM, DM, DM, WB + WO_O + l * W_O_EL, nullptr, MAP_NAT);
        }
        if (LATE_CONV < 2) base = conv_matrix(F, base, ka->w_gate, ka->w_up, DM, DFF, 2 * DFF, WB + WO_GU, ka->ffn_norm, MAP_GU);
        if (!LATE_CONV) base = conv_matrix(F, base, ka->w_down, nullptr, DFF, DM, DM, WB + WO_D, nullptr, MAP_NAT);
        bf16* XB = WSP(bf16, WS_XB); float* PART = WSP(float, WS_PART); float* COS = WSP(float, WS_COS); float* SIN = WSP(float, WS_SIN);
        const float* x = ka->x; const int* pos = ka->pos;
        for (long mrow0 = gw; mrow0 < M; mrow0 += 4 * NGW) {
            f32x4 v[4][4];
#pragma unroll
            for (int r = 0; r < 4; ++r) { const GAS f32x4* xr = (const GAS f32x4*)(x + (size_t)(mrow0 + r * NGW) * DM) + F.lane;
#pragma unroll
                for (int j = 0; j < 4; ++j) v[r][j] = __builtin_nontemporal_load(xr + 64 * j); }
#pragma unroll
            for (int r = 0; r < 4; ++r) { const long mrow = mrow0 + r * NGW; float s = 0.f;
#pragma unroll
                for (int j = 0; j < 4; ++j) s += (v[r][j][0] * v[r][j][0] + v[r][j][1] * v[r][j][1]) + (v[r][j][2] * v[r][j][2] + v[r][j][3] * v[r][j][3]);
                s = wave_sum(s);
                GAS unsigned long long* o8 = (GAS unsigned long long*)(XB + (size_t)mrow * DM) + F.lane;
#pragma unroll
                for (int j = 0; j < 4; ++j) o8[64 * j] = (unsigned long long)pk2(v[r][j][0], v[r][j][1]) | ((unsigned long long)pk2(v[r][j][2], v[r][j][3]) << 32);
                if (F.lane < 16) PART[mrow * 16 + F.lane] = F.lane == 0 ? s : 0.f; }
        }
        static_assert(M * 16 == 2 * GRID * 512, "two rope table entries per thread");
#pragma unroll
        for (int q = 0; q < 2; ++q) { const int i = bid * 512 + F.tid + q * GRID * 512;
            const int f = i & 15; const float inv = powf(10000.0f, -(float)(2 * f) / 32.0f); const float ang = (float)(q ? rpos1 : rpos0) * inv;
            COS[i] = cosf(ang); SIN[i] = sinf(ang); }
    }
#endif
    GRID_BAR();

#pragma unroll 1
    for (int l = 0; l < 2; ++l) {
#ifndef SKIP_P1
        {
            PHASE_BEGIN();
            pg8::Gemm g{WSP(bf16, WS_XB), WSP(bf16, WS_W) + WO_IN + l * W_IN_EL, DM, DM}; pg8::StaticOrder S; S.init(M, DINP - 256, GRID, bid);
            pg8::EpiIn E{ws};
            pg8::RsPart<16> R{WSP(float, WS_PART), 1.0f / DM};
            for (int rep_ = 0; rep_ < DUP1; ++rep_)
            pg8::gemm_phase<pg8::EpiIn, pg8::StaticOrder, pg8::RsPart<16>, false, true>(F.wave, F.lds + RING_OFF, rsb, g, S, E, R, nullptr, 0);
        }
#endif
        GRID_BAR();
        if (STOP_AFTER == 1) { PHASE_BEGIN(); dump_fold(ka->out, WSP(bf16, WS_CU), 512, 512, WSP(bf16, WS_S1), 1024, 1024, WSP(bf16, WS_S2), 1024, 1024, WSP(bf16, WS_ZATT), 1024, 512, bid, F.tid); return; }
        if (STOP_AFTER == 11) { PHASE_BEGIN(); dump_fold(ka->out, WSP(bf16, WS_CQ), 384, 384, WSP(bf16, WS_CKV), 256, 256, WSP(bf16, WS_K), 768, 768, nullptr, 0, 1, bid, F.tid); return; }
#ifndef SKIP_P2
        {
            for (int rep2_ = 0; rep2_ < DUP2; ++rep2_) {
            { PHASE_BEGIN();
              if (bid < 64) {
                pg8::Gemm g{WSP(bf16, WS_XB), WSP(bf16, WS_W) + WO_IN + l * W_IN_EL, DM, DM}; pg8::OneTileOrder S{bid, 16, true};
                pg8::EpiIn E{ws}; pg8::RsPart<16> R{WSP(float, WS_PART), 1.0f / DM};
                pg8::gemm_phase<pg8::EpiIn, pg8::OneTileOrder, pg8::RsPart<16>, false, false>(F.wave, F.lds + RING_OFF, rsb, g, S, E, R, nullptr, 0);
              } else {
                { pg8::Gemm g{WSP(bf16, WS_CKV), WSP(bf16, WS_W) + WO_UKV + l * W_UKV_EL, KVLORA, KVLORA}; pg8::StaticOrder S; S.init(M, 1024, GRID - 64, bid - 64);
                  pg8::EpiKV E{WSP(bf16, WS_K), WSP(bf16, WS_V), WSP(float, WS_SSQKV)}; pg8::RsPart<4> R{WSP(float, WS_SSQKV), 1.0f / KVLORA};
                  pg8::gemm_phase<pg8::EpiKV, pg8::StaticOrder, pg8::RsPart<4>, false, true>(F.wave, F.lds + RING_OFF, rsb, g, S, E, R, nullptr, 0); }
                { pg8::Gemm g{WSP(bf16, WS_CQ), WSP(bf16, WS_W) + WO_UQ + l * W_UQ_EL, QLORA, QLORA}; pg8::StaticOrder S; S.init(M, 768, GRID - 64, (bid - 64 + 64) % (GRID - 64));
                  pg8::EpiQ E{WSP(bf16, WS_Q), WSP(float, WS_COS), WSP(float, WS_SIN), WSP(float, WS_SSQQ)}; pg8::RsPart<8> R{WSP(float, WS_SSQQ), 1.0f / QLORA};
                  pg8::gemm_phase<pg8::EpiQ, pg8::StaticOrder, pg8::RsPart<8>, false, true>(F.wave, F.lds + RING_OFF, rsb, g, S, E, R, nullptr, 0); }
              } }
            if (LATE_CONV >= 2 && l == 1) { PHASE_BEGIN();
                if (bid >= 128) { long base = 0; bf16* WB = WSP(bf16, WS_W);
                    base = conv_matrix(F, base, ka->w_conv_out + (size_t)DCONV * DM, nullptr, DCONV, DM, DM, WB + WO_C + 2 * W_CM_EL, nullptr, MAP_NAT, 1024, bid - 128, 128);
                    base = conv_matrix(F, base, ka->w_mla_out + (size_t)512 * DM, nullptr, 512, DM, DM, WB + WO_C + 2 * W_CM_EL + 512, nullptr, MAP_NAT, 1024, bid - 128, 128);
                    base = conv_matrix(F, base, ka->w_o + (size_t)DM * DM, nullptr, DM, DM, DM, WB + WO_O + W_O_EL, nullptr, MAP_NAT, 0, bid - 128, 128); (void)base; } }
            if (LATE_CONV >= 2 && l == 0) { PHASE_BEGIN();
                if (bid >= 128) { long base = 0;
                    base = conv_matrix(F, base, ka->w_gate, ka->w_up, DM, DFF, 2 * DFF, WSP(bf16, WS_W) + WO_GU, ka->ffn_norm, MAP_GU, 0, bid - 128, 128); (void)base; } }
            }
        }
#endif
        GRID_BAR_WT();
        if (STOP_AFTER == 2) { PHASE_BEGIN(); dump_fold(ka->out, WSP(bf16, WS_Q), 768, 768, WSP(bf16, WS_K), 768, 768, WSP(bf16, WS_V), 512, 512, WSP(bf16, WS_ZATT), 1024, 512, bid, F.tid); return; }
#ifndef SKIP_P3
        {
            PHASE_BEGIN();
            const int bh = F.vcu >> 2, s = F.vcu & 3;
            for (int rep3_ = 0; rep3_ < DUP3; ++rep3_)
#ifdef ATTN_V2
                att::attn_pair(F.wave, bh / NH, bh % NH, s, 7 - s, WSP(bf16, WS_Q), WSP(bf16, WS_K), WSP(bf16, WS_V), WSP(bf16, WS_ZATT), (char*)lds + RING_OFF);
#else
                { const float* cw = ka->conv_w + (size_t)l * 3 * DCONV;
                  att2::attn_unit<8>(F.wave, bh / NH, bh % NH, s, WSP(bf16, WS_Q), WSP(bf16, WS_K), WSP(bf16, WS_V), WSP(bf16, WS_ZATT), (char*)lds + RING_OFF, WSP(bf16, WS_CU), cw, (long)F.vcu * 512);
                  att2::attn_unit<8>(F.wave, bh / NH, bh % NH, 7 - s, WSP(bf16, WS_Q), WSP(bf16, WS_K), WSP(bf16, WS_V), WSP(bf16, WS_ZATT), (char*)lds + RING_OFF, WSP(bf16, WS_CU), cw, (long)(GRID + F.vcu) * 512); }
#endif
        }
#endif
        GRID_BAR_WT();
        if (STOP_AFTER == 3) { PHASE_BEGIN(); dump_fold(ka->out, WSP(bf16, WS_ZATT), 1024, 1024, nullptr, 0, 1, nullptr, 0, 1, nullptr, 0, 1, bid, F.tid); return; }
#ifndef SKIP_P4
        for (int rep4_ = 0; rep4_ < DUP4; ++rep4_) {
            PHASE_BEGIN();
            pg8::Gemm g{WSP(bf16, WS_ZATT), WSP(bf16, WS_W) + WO_C + l * 2 * W_CM_EL, 1024, 1024}; pg8::StaticOrder S; S.init(M, DM, GRID, bid);
            pg8::EpiMerge E{WSP(bf16, WS_S1), WSP(bf16, WS_S2), WSP(bf16, WS_MERGED)}; pg8::RsNone R;
            pg8::gemm_phase<pg8::EpiMerge, pg8::StaticOrder, pg8::RsNone, false, false>(F.wave, F.lds + RING_OFF, rsb, g, S, E, R, nullptr, 0);
        }
#endif
        GRID_BAR_WT();
        if (STOP_AFTER == 4) { PHASE_BEGIN(); dump_fold(ka->out, WSP(bf16, WS_MERGED), 1024, 1024, nullptr, 0, 1, nullptr, 0, 1, nullptr, 0, 1, bid, F.tid); return; }
#ifndef SKIP_P5
        {
            { PHASE_BEGIN();
              pg8::Gemm g{WSP(bf16, WS_MERGED), WSP(bf16, WS_W) + WO_O + l * W_O_EL, DM, DM}; pg8::StaticOrder S; S.init(M, DM, GRID, bid);
              pg8::RsNone R;
              if (l == 0) { pg8::EpiRes<false> E{WSP(bf16, WS_XB), WSP(bf16, WS_XB), WSP(float, WS_PART)};
                for (int rep5_ = 0; rep5_ < 1; ++rep5_)
                pg8::gemm_phase<pg8::EpiRes<false>, pg8::StaticOrder, pg8::RsNone, false, false>(F.wave, F.lds + RING_OFF, rsb, g, S, E, R, nullptr, 0); }
              else { pg8::EpiRes<true> E{WSP(bf16, WS_XB), WSP(bf16, WS_X1B), WSP(float, WS_PART)};
                pg8::gemm_phase<pg8::EpiRes<true>, pg8::StaticOrder, pg8::RsNone, false, false>(F.wave, F.lds + RING_OFF, rsb, g, S, E, R, nullptr, 0);
                if (F.tid == 0) (void)__hip_atomic_fetch_add((unsigned*)(ws + WS_CTL) + CW_RDY2, 1u, __ATOMIC_RELAXED, __HIP_MEMORY_SCOPE_AGENT); } }
            if (l == 1) for (int repc_ = 0; repc_ < DUPC; ++repc_) {
                PHASE_BEGIN();
                long base = 0;
#pragma unroll 1
                for (int e = 0; e < NE; ++e) {
                    base = conv_matrix(F, base, ka->w_gate_e + (size_t)e * DM * DFFE, ka->w_up_e + (size_t)e * DM * DFFE, DM, DFFE, 2 * DFFE, WSP(bf16, WS_WGUE) + (size_t)e * 2 * DFFE * DM, ka->ffn_norm + DM, MAP_GU);
                    base = conv_matrix(F, base, ka->w_down_e + (size_t)e * DFFE * DM, nullptr, DFFE, DM, DM, WSP(bf16, WS_WDE) + (size_t)e * DM * DFFE, nullptr, MAP_NAT);
                }
            }
        }
#endif
        if (l == 0) GRID_BAR();
        if (STOP_AFTER == 5) return;
        if (l == 0) {
#ifndef SKIP_P6
            {
                PHASE_BEGIN();
                pg8::Gemm g{WSP(bf16, WS_XB), WSP(bf16, WS_W) + WO_GU, DM, DM}; pg8::StaticOrder S; S.init(M, 2 * DFF, GRID, bid);
                pg8::EpiUp E{WSP(bf16, WS_HD), DFF, nullptr}; pg8::RsPart<16> R{WSP(float, WS_PART), 1.0f / DM};
                for (int rep_ = 0; rep_ < DUP6; ++rep_)
                pg8::gemm_phase<pg8::EpiUp, pg8::StaticOrder, pg8::RsPart<16>, false, true>(F.wave, F.lds + RING_OFF, rsb, g, S, E, R, nullptr, 0);
                if (LATE_CONV && bid >= S.nwg - 5 * GRID) {
                    bf16* WB = WSP(bf16, WS_W); const int wg = bid - (S.nwg - 5 * GRID), nw = 6 * GRID - S.nwg; long base = 0;
                    base = conv_matrix(F, base, ka->w_down, nullptr, DFF, DM, DM, WB + WO_D, nullptr, MAP_NAT, 0, wg, nw);
                    base = conv_matrix(F, base, ka->w_in + (size_t)DM * DIN, nullptr, DM, DIN, DINP, WB + WO_IN + W_IN_EL, ka->attn_norm + DM, MAP_WIN, 0, wg, nw);
                    base = conv_matrix(F, base, ka->w_uq + (size_t)QLORA * 768, nullptr, QLORA, 768, 768, WB + WO_UQ + W_UQ_EL, ka->q_norm + QLORA, MAP_WUQ, 0, wg, nw);
                    base = conv_matrix(F, base, ka->w_ukv + (size_t)KVLORA * 1024, nullptr, KVLORA, 1024, 1024, WB + WO_UKV + W_UKV_EL, ka->kv_norm + KVLORA, MAP_NAT, 0, wg, nw);
                }
            }
#endif
            GRID_BAR_WT();
            if (STOP_AFTER == 6) { PHASE_BEGIN(); dump_fold(ka->out, WSP(bf16, WS_HD), 2816, 1024, WSP(bf16, WS_HD) + 1024, 2816, 1024, WSP(bf16, WS_HD) + 1792, 2816, 1024, nullptr, 0, 1, bid, F.tid); return; }
#ifndef SKIP_P7
            {
                PHASE_BEGIN();
                pg8::Gemm g{WSP(bf16, WS_HD), WSP(bf16, WS_W) + WO_D, DFF, DFF}; pg8::StaticOrder S; S.init(M, DM, GRID, bid);
                pg8::EpiRes<false> E{WSP(bf16, WS_XB), WSP(bf16, WS_XB), WSP(float, WS_PART)}; pg8::RsNone R;
                pg8::gemm_phase<pg8::EpiRes<false>, pg8::StaticOrder, pg8::RsNone, false, false>(F.wave, F.lds + RING_OFF, rsb, g, S, E, R, nullptr, 0);
            }
#endif
            GRID_BAR();
            if (STOP_AFTER == 7) return;
        } else {
#ifndef SKIP_PR
            {
                PHASE_BEGIN();
                if (F.tid == 0) { unsigned* bar_ = (unsigned*)(ws + WS_CTL) + CW_BAR; unsigned* rdy_ = (unsigned*)(ws + WS_CTL) + CW_RDY2; XB_SPIN(xb_ld(rdy_) < (unsigned)GRID, bar_);
                    __builtin_amdgcn_fence(__ATOMIC_ACQUIRE, "agent"); asm volatile("s_waitcnt vmcnt(0)" ::: "memory"); }
                __syncthreads();
                LAS int* sE = (LAS int*)(F.lds + RING_OFF); LAS float* sW = (LAS float*)(F.lds + RING_OFF + 1024);
                unsigned* CNT = (unsigned*)(ws + WS_CTL) + CW_CNT;
                float* RSTD1 = WSP(float, WS_RSTD1); int* TOPE = WSP(int, WS_TOPE); float* TOPW = WSP(float, WS_TOPW); int* TOPP = WSP(int, WS_TOPP); int* LIST = WSP(int, WS_LIST);
                const bf16* xo = WSP(bf16, WS_X1B);
                float gr[16][8];
                { const float* fn = ka->ffn_norm + DM; const float* router = ka->router; f32x4 ra_[16], rb_[16]; f32x4 gk_[4];
#pragma unroll
                for (int j = 0; j < 4; ++j) { gk_[j] = *(const f32x4*)(fn + 4 * F.lane + 256 * j);
#pragma unroll
                    for (int i = 0; i < 4; ++i) { const int k = 4 * F.lane + 256 * j + i; ra_[j * 4 + i] = *(const f32x4*)(router + k * 8); rb_[j * 4 + i] = *(const f32x4*)(router + k * 8 + 4); } }
#pragma unroll
                for (int j = 0; j < 4; ++j)
#pragma unroll
                    for (int i = 0; i < 4; ++i) { const float gk = gk_[j][i];
#pragma unroll
                        for (int e = 0; e < 4; ++e) { gr[j * 4 + i][e] = gk * ra_[j * 4 + i][e]; gr[j * 4 + i][4 + e] = gk * rb_[j * 4 + i][e]; } } }
                for (int grp = F.vcu; grp < M / 64; grp += GRID) {
                    const int tok0 = grp * 64 + F.wave * 8;
#pragma unroll 1
                    for (int tt0 = 0; tt0 < 8; tt0 += 2) {
                        v2u xw_[2][4];
#pragma unroll
                        for (int r = 0; r < 2; ++r) { const GAS v2u* xr = (const GAS v2u*)(xo + (size_t)(tok0 + tt0 + r) * DM) + F.lane;
#pragma unroll
                            for (int j = 0; j < 4; ++j) xw_[r][j] = xr[64 * j]; }
#pragma unroll
                        for (int r = 0; r < 2; ++r) { const int tt = tt0 + r, tok = tok0 + tt;
                        float s = 0.f, lg[8];
#pragma unroll
                        for (int e = 0; e < 8; ++e) lg[e] = 0.f;
#pragma unroll
                        for (int j = 0; j < 4; ++j) { const v2u w = xw_[r][j]; const f32x4 v = {bflo(w.x), bfhi(w.x), bflo(w.y), bfhi(w.y)}; s += (v[0] * v[0] + v[1] * v[1]) + (v[2] * v[2] + v[3] * v[3]);
#pragma unroll
                            for (int i = 0; i < 4; ++i)
#pragma unroll
                                for (int e = 0; e < 8; ++e) lg[e] += v[i] * gr[j * 4 + i][e]; }
                        s = wave_sum(s);
#pragma unroll
                        for (int e = 0; e < 8; ++e) lg[e] = wave_sum(lg[e]);
                        const float rstd = 1.0f / sqrtf(s * (1.0f / DM) + EPS);
                        int e0 = 0; float v0 = lg[0];
#pragma unroll
                        for (int e = 1; e < 8; ++e) if (lg[e] > v0) { v0 = lg[e]; e0 = e; }
                        int e1 = -1; float v1 = -INFINITY;
#pragma unroll
                        for (int e = 0; e < 8; ++e) if (e != e0 && lg[e] > v1) { v1 = lg[e]; e1 = e; }
                        const float w0 = 1.0f / (1.0f + expf((v1 - v0) * rstd));
                        if (F.lane == 0) { const int li = F.wave * 8 + tt; sE[li * 2] = e0; sE[li * 2 + 1] = e1; sW[li * 2] = w0; sW[li * 2 + 1] = 1.0f - w0; RSTD1[tok] = rstd; }
                        }
                    }
                    LDS_WAIT(); __syncthreads();
                    if (F.wave == 0) {
                        const int tok = grp * 64 + F.lane; const int e0 = sE[F.lane * 2], e1 = sE[F.lane * 2 + 1];
                        const unsigned long long lt = (1ull << F.lane) - 1ull;
                        int p0 = 0, p1 = 0; unsigned myc = 0u;
#pragma unroll
                        for (int e = 0; e < 8; ++e) { const unsigned c = (unsigned)(__popcll(__ballot(e0 == e)) + __popcll(__ballot(e1 == e))); if (F.lane == e) myc = c; }
                        unsigned myb = 0u;
                        if (F.lane < 8 && myc) myb = __hip_atomic_fetch_add(CNT + F.lane, myc, RLX_AGENT);
#pragma unroll
                        for (int e = 0; e < 8; ++e) { const unsigned long long m0 = __ballot(e0 == e), m1 = __ballot(e1 == e);
                            const unsigned b0 = (unsigned)__builtin_amdgcn_readlane((int)myb, e);
                            if (e0 == e) p0 = (int)b0 + __popcll(m0 & lt);
                            if (e1 == e) p1 = (int)b0 + __popcll(m0) + __popcll(m1 & lt); }
                        LIST[e0 * M + p0] = tok; LIST[e1 * M + p1] = tok;
                        TOPE[tok * 2] = e0; TOPE[tok * 2 + 1] = e1; TOPP[tok * 2] = p0; TOPP[tok * 2 + 1] = p1; TOPW[tok * 2] = sW[F.lane * 2]; TOPW[tok * 2 + 1] = sW[F.lane * 2 + 1];
                    }
                    __syncthreads();
                }
            }
#endif
            GRID_BAR();
#ifndef SKIP_PMU
            for (int repm_ = 0; repm_ < DUPM; ++repm_) {
                PHASE_BEGIN();
                MOE_TABLE();
                { pg8::Gemm g{WSP(bf16, WS_X1B), WSP(bf16, WS_WGUE), DM, DM}; pg8::MoeOrderT<true> S; S.init((const LAS int*)(F.lds + MOETAB_OFF), 2 * DFFE, (unsigned)(2 * DFFE * DM * 2), GRID, bid, MOE_NEARLY());
                  pg8::EpiUpT<true> E{WSP(bf16, WS_HMOE), DFFE, (unsigned*)(ws + WS_CTL) + CW_RDY}; pg8::RsGather R{WSP(float, WS_RSTD1), WSP(int, WS_LIST)};
                  pg8::gemm_phase<pg8::EpiUpT<true>, pg8::MoeOrderT<true>, pg8::RsGather, true, true>(F.wave, F.lds + RING_OFF, rsb, g, S, E, R, WSP(int, WS_LIST), 0); }
#ifndef NO_EARLY_DOWN
                { const int nearly = MOE_NEARLY(); const int j = GRID - 1 - bid;
                  if (j < nearly) {
                    if (F.tid == 0) { unsigned* bar_ = (unsigned*)(ws + WS_CTL) + CW_BAR; unsigned* rdy_ = (unsigned*)(ws + WS_CTL) + CW_RDY; XB_SPIN(xb_ld(rdy_) < 88u * NWAVES, bar_);
                        __builtin_amdgcn_fence(__ATOMIC_ACQUIRE, "agent"); asm volatile("s_waitcnt vmcnt(0)" ::: "memory"); }
                    __syncthreads();
                    pg8::Gemm g{WSP(bf16, WS_HMOE), WSP(bf16, WS_WDE), DFFE, DFFE}; pg8::MoeOne S; S.O.init((const LAS int*)(F.lds + MOETAB_OFF), DM, (unsigned)(DM * DFFE * 2), GRID, bid); S.wg = j;
                    pg8::EpiY E{WSP(bf16, WS_Y)}; pg8::RsNone R;
                    pg8::gemm_phase<pg8::EpiY, pg8::MoeOne, pg8::RsNone, false, true>(F.wave, F.lds + RING_OFF, rsb, g, S, E, R, nullptr, 0);
                  } }
#endif
            }
#endif
            GRID_BAR_WT();
#ifndef SKIP_PMD
            for (int repm_ = 0; repm_ < DUPM; ++repm_) {
                PHASE_BEGIN();
                MOE_TABLE();
                pg8::Gemm g{WSP(bf16, WS_HMOE), WSP(bf16, WS_WDE), DFFE, DFFE}; pg8::MoeOrder S; S.init((const LAS int*)(F.lds + MOETAB_OFF), DM, (unsigned)(DM * DFFE * 2), GRID, bid, MOE_NEARLY());
                pg8::EpiY E{WSP(bf16, WS_Y)}; pg8::RsNone R;
                pg8::gemm_phase<pg8::EpiY, pg8::MoeOrder, pg8::RsNone, false, true>(F.wave, F.lds + RING_OFF, rsb, g, S, E, R, nullptr, 0);
            }
#endif
            GRID_BAR_WT();
#ifndef SKIP_PF
            {
                PHASE_BEGIN();
                unsigned* CNT = (unsigned*)(ws + WS_CTL) + CW_CNT;
                LAS int* tbl = (LAS int*)(F.lds + RING_OFF);
                if (F.wave == 0) { int n8 = 0, t = 0; if (F.lane < NE) n8 = (int)__hip_atomic_load(CNT + F.lane, RLX_AGENT);
#pragma unroll
                    for (int j = 0; j < NE; ++j) { if (F.lane == 0) tbl[j] = t; t += (__builtin_amdgcn_readlane(n8, j) + 255) / 256; } }
                LDS_WAIT(); __syncthreads();
                const int* TOPE = WSP(int, WS_TOPE); const float* TOPW = WSP(float, WS_TOPW); const int* TOPP = WSP(int, WS_TOPP); const bf16* YB = WSP(bf16, WS_Y);
                float* out = ka->out; const float* fng = ka->final_norm; const bf16* X1 = WSP(bf16, WS_X1B);
                int me0 = 0, me1 = 0, mp0 = 0, mp1 = 0; float mw0 = 0.f, mw1 = 0.f;
                if (F.lane < 8) { const long mr = gw + (long)F.lane * NGW; me0 = TOPE[mr * 2]; me1 = TOPE[mr * 2 + 1]; mp0 = TOPP[mr * 2]; mp1 = TOPP[mr * 2 + 1]; mw0 = TOPW[mr * 2]; mw1 = TOPW[mr * 2 + 1]; }
                static_assert(M == 8 * GRID * NWAVES, "eight rows per wave");
                f32x4 gnv[4];
#pragma unroll
                for (int j = 0; j < 4; ++j) gnv[j] = *((const f32x4*)fng + F.lane + 64 * j);
#pragma unroll
                for (int it = 0; it < 2; ++it) { const long mrow0 = gw + (long)(4 * it) * NGW;
                    v2u xx[4][4], ya[4][4], yb[4][4]; float w0[4], w1[4];
#pragma unroll
                    for (int r = 0; r < 4; ++r) { const long mrow = mrow0 + r * NGW; const int li = 4 * it + r;
                        const int e0 = __builtin_amdgcn_readlane(me0, li), e1 = __builtin_amdgcn_readlane(me1, li);
                        w0[r] = __builtin_bit_cast(float, __builtin_amdgcn_readlane(__builtin_bit_cast(int, mw0), li)); w1[r] = __builtin_bit_cast(float, __builtin_amdgcn_readlane(__builtin_bit_cast(int, mw1), li));
                        const size_t s0 = (size_t)tbl[e0] * 256 + __builtin_amdgcn_readlane(mp0, li), s1 = (size_t)tbl[e1] * 256 + __builtin_amdgcn_readlane(mp1, li);
                        const GAS v2u* xr = (const GAS v2u*)(X1 + (size_t)mrow * DM) + F.lane;
                        const GAS v2u* y0 = (const GAS v2u*)(YB + s0 * DM) + F.lane; const GAS v2u* y1 = (const GAS v2u*)(YB + s1 * DM) + F.lane;
#pragma unroll
                        for (int j = 0; j < 4; ++j) { xx[r][j] = __builtin_nontemporal_load(xr + 64 * j); ya[r][j] = __builtin_nontemporal_load(y0 + 64 * j); yb[r][j] = __builtin_nontemporal_load(y1 + 64 * j); } }
#pragma unroll
                    for (int r = 0; r < 4; ++r) { const long mrow = mrow0 + r * NGW; GAS f32x4* xw = (GAS f32x4*)(out + (size_t)mrow * DM) + F.lane;
                        f32x4 v[4]; float s = 0.f;
#pragma unroll
                        for (int j = 0; j < 4; ++j) { const v2u a0 = ya[r][j], a1 = yb[r][j], x0 = xx[r][j];
                            v[j][0] = bflo(x0.x) + w0[r] * bflo(a0.x) + w1[r] * bflo(a1.x); v[j][1] = bfhi(x0.x) + w0[r] * bfhi(a0.x) + w1[r] * bfhi(a1.x);
                            v[j][2] = bflo(x0.y) + w0[r] * bflo(a0.y) + w1[r] * bflo(a1.y); v[j][3] = bfhi(x0.y) + w0[r] * bfhi(a0.y) + w1[r] * bfhi(a1.y);
                            s += (v[j][0] * v[j][0] + v[j][1] * v[j][1]) + (v[j][2] * v[j][2] + v[j][3] * v[j][3]); }
                        s = wave_sum(s); const float rstd = 1.0f / sqrtf(s * (1.0f / DM) + EPS);
#pragma unroll
                        for (int j = 0; j < 4; ++j) __builtin_nontemporal_store(v[j] * rstd * gnv[j], xw + 64 * j); }
                }
            }
#endif
        }
    }
}


extern "C" void kernel_launch(void* const* d_in, const int* in_sizes, int n_in, void* d_out, int out_size, void* d_ws, size_t ws_size, hipStream_t stream) {
    static int grid = 0;
    if (grid == 0) {
        if (n_in != 21 || in_sizes[0] != M * DM || out_size != M * DM || ws_size < WS_END) { fprintf(stderr, "kernel_launch: unexpected problem (n_in %d, ws %zu < %zu?)\n", n_in, ws_size, (size_t)WS_END); grid = -1; return; }
        int dev = 0, cus = 0;
        if (hipGetDevice(&dev) != hipSuccess || hipDeviceGetAttribute(&cus, hipDeviceAttributeMultiprocessorCount, dev) != hipSuccess) { grid = -1; return; }
        if (hipFuncSetAttribute((const void*)trunk_fwd, hipFuncAttributeMaxDynamicSharedMemorySize, LDS_BYTES) != hipSuccess) { fprintf(stderr, "kernel_launch: hipFuncSetAttribute failed\n"); grid = -1; return; }
        int per_cu = 0;
        (void)hipOccupancyMaxActiveBlocksPerMultiprocessor(&per_cu, (const void*)trunk_fwd, NWAVES * 64, LDS_BYTES);
        (void)hipGetLastError();
        if (cus < GRID || per_cu < 1) { fprintf(stderr, "kernel_launch: needs %d resident workgroups (cus %d, per_cu %d)\n", GRID, cus, per_cu); }
        grid = GRID;
    }
    if (grid < 0) return;
    (void)hipMemsetAsync((char*)d_ws + WS_CTL, 0, CTL_ZERO_BYTES, stream);
    Args a{};
    a.x = (const float*)d_in[0]; a.pos = (const int*)d_in[1]; a.attn_norm = (const float*)d_in[2]; a.w_in = (const float*)d_in[3]; a.conv_w = (const float*)d_in[4];
    a.w_conv_out = (const float*)d_in[5]; a.q_norm = (const float*)d_in[6]; a.w_uq = (const float*)d_in[7]; a.kv_norm = (const float*)d_in[8]; a.w_ukv = (const float*)d_in[9];
    a.w_mla_out = (const float*)d_in[10]; a.w_o = (const float*)d_in[11]; a.ffn_norm = (const float*)d_in[12]; a.w_gate = (const float*)d_in[13]; a.w_up = (const float*)d_in[14];
    a.w_down = (const float*)d_in[15]; a.router = (const float*)d_in[16]; a.w_gate_e = (const float*)d_in[17]; a.w_up_e = (const float*)d_in[18]; a.w_down_e = (const float*)d_in[19];
    a.final_norm = (const float*)d_in[20]; a.out = (float*)d_out; a.ws = (unsigned char*)d_ws;
    hipLaunchKernelGGL(trunk_fwd, dim3(grid), dim3(NWAVES * 64), LDS_BYTES, stream, a);
}
```
